# Optimizing an MI355X kernel written in HIP

```python
import math
import jax, jax.numpy as jnp
from jax import lax
import numpy as np

D_MODEL = 2048
BATCH = 2
SEQ = 16384
DEPTH = 4
DEC_BATCH = 4
DEC_SEQ = 2048
PAST_LEN = 128

HEAD_DIM = 128
GROUP_HEADS = 4
GROUP_W = GROUP_HEADS * HEAD_DIM
N_GROUPS = 4
D_MIX = N_GROUPS * GROUP_W
F_W = GROUP_W
CONV_W = GROUP_W
CONV_K = 3
MLSTM_HEADS = 4
MLSTM_W = MLSTM_HEADS * HEAD_DIM
MLSTM_CHUNK = 128
ATTN_Q_HEADS = 4
ATTN_KV_HEADS = 2
ATTN_W = ATTN_Q_HEADS * HEAD_DIM
Q_BLOCK = 128
GRID_W = 64
ROPE_THETA = 10000.0
ROPE_FREQS = HEAD_DIM // 4
CA_HEADS = 4
CA_W = CA_HEADS * HEAD_DIM
N_MEM = 256
D_FF = 4 * D_MODEL
RMS_EPS = 1e-6
IN_SIZES = (F_W, CONV_W, CONV_W, CONV_W, MLSTM_W, MLSTM_W, MLSTM_W, MLSTM_W, 2 * MLSTM_HEADS, 2 * MLSTM_HEADS, ATTN_Q_HEADS * HEAD_DIM, ATTN_KV_HEADS * HEAD_DIM, ATTN_KV_HEADS * HEAD_DIM)
N_IN = F_W + 3 * CONV_W + 4 * MLSTM_W + 4 * MLSTM_HEADS + (ATTN_Q_HEADS + 2 * ATTN_KV_HEADS) * HEAD_DIM

kernel_name = 'hybrid_parallel_group_encoder'


def rms_norm(x, g):
    xf = x.astype(jnp.float32)
    y = xf * lax.rsqrt(jnp.mean(xf * xf, axis=-1, keepdims=True) + RMS_EPS)
    return (y * g.astype(jnp.float32)).astype(x.dtype)


def head_norm(y):
    B, S, W = y.shape
    yf = y.astype(jnp.float32).reshape(B, S, W // HEAD_DIM, HEAD_DIM)
    yf = yf * lax.rsqrt(jnp.mean(yf * yf, axis=-1, keepdims=True) + RMS_EPS)
    return yf.reshape(B, S, W).astype(y.dtype)


def axial_rope_tables(n_tok):
    rows = n_tok // GRID_W
    row = jnp.repeat(jnp.arange(rows), GRID_W).astype(jnp.float32)
    col = jnp.tile(jnp.arange(GRID_W), rows).astype(jnp.float32)
    inv = ROPE_THETA ** (-jnp.arange(ROPE_FREQS, dtype=jnp.float32) / ROPE_FREQS)
    ang = jnp.stack([row[:, None] * inv, col[:, None] * inv], axis=1)[:, :, None, :]
    return jnp.cos(ang), jnp.sin(ang)


def apply_axial_rope(x, cos, sin):
    xs = x.astype(jnp.float32).reshape(x.shape[:-1] + (2, 2, ROPE_FREQS))
    rot = jnp.concatenate([-xs[..., 1:2, :], xs[..., 0:1, :]], axis=-2)
    return (xs * cos + rot * sin).reshape(x.shape)


def fourier_heads(a):
    B, S, _ = a.shape
    af = a.astype(jnp.float32).reshape(B, S, GROUP_HEADS, HEAD_DIM)
    return jnp.fft.fft2(af, axes=(1, 3), norm='ortho').real.reshape(B, S, F_W).astype(a.dtype)


def short_conv(z, w, b):
    zp = jnp.pad(z, ((0, 0), (1, 1), (0, 0)))
    return zp[:, :-2] * w[0] + zp[:, 1:-1] * w[1] + zp[:, 2:] * w[2] + b


def mlstm_chunkwise(q, k, v, li, lf):
    B, H, S, d = q.shape
    L = MLSTM_CHUNK
    nc = S // L
    q = q.reshape(B, H, nc, L, d)
    k = k.reshape(B, H, nc, L, d)
    v = v.reshape(B, H, nc, L, d)
    li = li.reshape(B, H, nc, L)
    b = jnp.cumsum(lf.reshape(B, H, nc, L), axis=-1)
    g = b[..., -1]
    causal = jnp.tril(jnp.ones((L, L), dtype=bool))
    dmat = jnp.where(causal, b[..., :, None] - b[..., None, :] + li[..., None, :], -jnp.inf)
    w_end = g[..., None] - b + li
    m_loc = jnp.max(w_end, axis=-1)
    e = jnp.exp(w_end - m_loc[..., None])
    ke = k * e[..., None]
    c_loc = jnp.einsum('bhcld,bhcle->bhcde', ke, v)
    n_loc = jnp.sum(ke, axis=3)

    def step(carry, inp):
        c, n, m = carry
        c_l, n_l, m_l, g_c = inp
        m_new = jnp.maximum(g_c + m, m_l)
        a = jnp.exp(g_c + m - m_new)
        bb = jnp.exp(m_l - m_new)
        c_new = a[..., None, None] * c + bb[..., None, None] * c_l
        n_new = a[..., None] * n + bb[..., None] * n_l
        return (c_new, n_new, m_new), (c, n, m)

    init = (jnp.zeros((B, H, d, d), jnp.float32), jnp.zeros((B, H, d), jnp.float32), jnp.zeros((B, H), jnp.float32))
    xs = (jnp.moveaxis(c_loc, 2, 0), jnp.moveaxis(n_loc, 2, 0), jnp.moveaxis(m_loc, 2, 0), jnp.moveaxis(g, 2, 0))
    _, (c_prev, n_prev, m_prev) = lax.scan(step, init, xs)
    c_prev = jnp.moveaxis(c_prev, 0, 2)
    n_prev = jnp.moveaxis(n_prev, 0, 2)
    m_prev = jnp.moveaxis(m_prev, 0, 2)
    inter_log = b + m_prev[..., None]
    m_t = jnp.maximum(inter_log, jnp.max(dmat, axis=-1))
    p = jnp.exp(dmat - m_t[..., None])
    inter_w = jnp.exp(inter_log - m_t)
    a_mat = p * jnp.einsum('bhcld,bhcsd->bhcls', q, k)
    num = jnp.einsum('bhcls,bhcsd->bhcld', a_mat, v) + inter_w[..., None] * jnp.einsum('bhcld,bhcde->bhcle', q, c_prev)
    den = jnp.sum(a_mat, axis=-1) + inter_w * jnp.einsum('bhcld,bhcd->bhcl', q, n_prev)
    h = num / jnp.maximum(jnp.abs(den), jnp.exp(-m_t))[..., None]
    return h.reshape(B, H, S, d)


def bidir_mlstm(mq, mk, mv, mi, mf, i_bias, f_bias):
    B, S, _ = mq.shape

    def heads(t):
        return t.astype(jnp.float32).reshape(B, S, MLSTM_HEADS, HEAD_DIM).transpose(0, 2, 1, 3)

    q = heads(mq)
    k = heads(mk) * (HEAD_DIM ** -0.5)
    v = heads(mv)
    li = (mi.astype(jnp.float32).reshape(B, S, 2, MLSTM_HEADS) + i_bias.astype(jnp.float32)).transpose(2, 0, 3, 1)
    lf = jax.nn.log_sigmoid(mf.astype(jnp.float32).reshape(B, S, 2, MLSTM_HEADS) + f_bias.astype(jnp.float32)).transpose(2, 0, 3, 1)
    h_fwd = mlstm_chunkwise(q, k, v, li[0], lf[0])
    h_bwd = jnp.flip(mlstm_chunkwise(jnp.flip(q, 2), jnp.flip(k, 2), jnp.flip(v, 2), jnp.flip(li[1], -1), jnp.flip(lf[1], -1)), 2)
    return (h_fwd + h_bwd).transpose(0, 2, 1, 3).reshape(B, S, MLSTM_W).astype(mq.dtype)


def axial_gqa(aq, ak, av, q_gain, k_gain, cos, sin):
    B, S, _ = aq.shape
    dt = aq.dtype
    G = ATTN_Q_HEADS // ATTN_KV_HEADS
    q = aq.reshape(B, S, ATTN_Q_HEADS, HEAD_DIM).transpose(0, 2, 1, 3)
    k = ak.reshape(B, S, ATTN_KV_HEADS, HEAD_DIM).transpose(0, 2, 1, 3)
    v = av.reshape(B, S, ATTN_KV_HEADS, HEAD_DIM).transpose(0, 2, 1, 3)
    q = apply_axial_rope(rms_norm(q, q_gain), cos, sin).astype(dt)
    k = apply_axial_rope(rms_norm(k, k_gain), cos, sin).astype(dt)
    nb = S // Q_BLOCK
    qb = q.reshape(B, ATTN_KV_HEADS, G, nb, Q_BLOCK, HEAD_DIM).transpose(3, 0, 1, 2, 4, 5)
    scale = HEAD_DIM ** -0.5

    def block(qi):
        s = jnp.einsum('bkgqd,bksd->bkgqs', qi, k).astype(jnp.float32) * scale
        p = jax.nn.softmax(s, axis=-1).astype(dt)
        return jnp.einsum('bkgqs,bksd->bkgqd', p, v)

    o = lax.map(block, qb)
    return o.transpose(1, 0, 4, 2, 3, 5).reshape(B, S, ATTN_W)


def token_mixers(h, cos, sin, w_in, conv_w, conv_b, i_bias, f_bias, q_gain, k_gain, out_gain, w_out):
    u = h @ w_in
    cuts = np.cumsum(IN_SIZES)[:-1].tolist()
    a_in, cb, cc, cx, mq, mk, mv, mo, mi, mf, aq, ak, av = jnp.split(u, cuts, axis=-1)
    y_a = fourier_heads(a_in)
    y_b = cb * short_conv(cc * cx, conv_w, conv_b)
    y_c = bidir_mlstm(mq, mk, mv, mi, mf, i_bias, f_bias)
    y_d = axial_gqa(aq, ak, av, q_gain, k_gain, cos, sin)
    y = jnp.concatenate([head_norm(y_a), head_norm(y_b), jax.nn.sigmoid(mo) * head_norm(y_c), head_norm(y_d)], axis=-1) * out_gain
    return y @ w_out


def memory_cross_attn(h, mem_n, w_q, w_kv, q_gain, k_gain, w_o):
    B, S, _ = h.shape
    M = mem_n.shape[1]
    dt = h.dtype
    q = (h @ w_q).reshape(B, S, CA_HEADS, HEAD_DIM).transpose(0, 2, 1, 3)
    kv = (mem_n @ w_kv).reshape(B, M, 2, CA_HEADS, HEAD_DIM)
    k = kv[:, :, 0].transpose(0, 2, 1, 3)
    v = kv[:, :, 1].transpose(0, 2, 1, 3)
    q = rms_norm(q, q_gain)
    k = rms_norm(k, k_gain)
    s = jnp.einsum('bhqd,bhkd->bhqk', q, k).astype(jnp.float32) * (HEAD_DIM ** -0.5)
    p = jax.nn.softmax(s, axis=-1).astype(dt)
    o = jnp.einsum('bhqk,bhkd->bhqd', p, v).transpose(0, 2, 1, 3).reshape(B, S, CA_W)
    return o @ w_o


def trunk(x, mem, g_mix, w_in, conv_w, conv_b, i_bias, f_bias, attn_q_norm, attn_k_norm, out_gain, w_out, g_ca, g_mem, w_ca_q, w_ca_kv, ca_q_norm, ca_k_norm, w_ca_o, g_mlp, w_up, w_down):
    cos, sin = axial_rope_tables(x.shape[1])
    for l in range(DEPTH):
        x = x + token_mixers(rms_norm(x, g_mix[l]), cos, sin, w_in[l], conv_w[l], conv_b[l], i_bias[l], f_bias[l], attn_q_norm[l], attn_k_norm[l], out_gain[l], w_out[l])
        x = x + memory_cross_attn(rms_norm(x, g_ca[l]), rms_norm(mem, g_mem[l]), w_ca_q[l], w_ca_kv[l], ca_q_norm[l], ca_k_norm[l], w_ca_o[l])
        h = rms_norm(x, g_mlp[l])
        x = x + jnp.square(jax.nn.relu(h @ w_up[l])) @ w_down[l]
    return x


def setup_inputs(seed: int = 0) -> dict:
    key = jax.random.key(seed)
    ks = jax.random.split(key, 32)

    def nrm(k, shape, scale):
        return jax.random.normal(k, shape, jnp.float32) * scale

    def gain(k, shape):
        return 1.0 + 0.02 * jax.random.normal(k, shape, jnp.float32)

    return {
        'x_prompt': nrm(ks[0], (BATCH, SEQ, D_MODEL), 1.0),
        'x_sample': nrm(ks[1], (DEC_BATCH, DEC_SEQ, D_MODEL), 1.0),
        'mem_prompt': nrm(ks[2], (BATCH, N_MEM, D_MODEL), 1.0),
        'mem_sample': nrm(ks[3], (DEC_BATCH, N_MEM, D_MODEL), 1.0),
        'g_mix': gain(ks[4], (DEPTH, D_MODEL)),
        'w_in': nrm(ks[5], (DEPTH, D_MODEL, N_IN), D_MODEL ** -0.5),
        'conv_w': nrm(ks[6], (DEPTH, CONV_K, CONV_W), CONV_K ** -0.5),
        'conv_b': nrm(ks[7], (DEPTH, CONV_W), 0.02),
        'i_bias': nrm(ks[8], (DEPTH, 2, MLSTM_HEADS), 0.1),
        'f_bias': jax.random.uniform(ks[9], (DEPTH, 2, MLSTM_HEADS), jnp.float32, 3.0, 6.0),
        'attn_q_norm': gain(ks[10], (DEPTH, HEAD_DIM)),
        'attn_k_norm': gain(ks[11], (DEPTH, HEAD_DIM)),
        'out_gain': gain(ks[12], (DEPTH, D_MIX)),
        'w_out': nrm(ks[13], (DEPTH, D_MIX, D_MODEL), D_MIX ** -0.5),
        'g_ca': gain(ks[14], (DEPTH, D_MODEL)),
        'g_mem': gain(ks[15], (DEPTH, D_MODEL)),
        'w_ca_q': nrm(ks[16], (DEPTH, D_MODEL, CA_W), D_MODEL ** -0.5),
        'w_ca_kv': nrm(ks[17], (DEPTH, D_MODEL, 2 * CA_W), D_MODEL ** -0.5),
        'ca_q_norm': gain(ks[18], (DEPTH, HEAD_DIM)),
        'ca_k_norm': gain(ks[19], (DEPTH, HEAD_DIM)),
        'w_ca_o': nrm(ks[20], (DEPTH, CA_W, D_MODEL), CA_W ** -0.5),
        'g_mlp': gain(ks[21], (DEPTH, D_MODEL)),
        'w_up': nrm(ks[22], (DEPTH, D_MODEL, D_FF), D_MODEL ** -0.5),
        'w_down': nrm(ks[23], (DEPTH, D_FF, D_MODEL), D_FF ** -0.5),
    }


def reference(x_prompt, x_sample, mem_prompt, mem_sample, g_mix, w_in, conv_w, conv_b, i_bias, f_bias, attn_q_norm, attn_k_norm, out_gain, w_out, g_ca, g_mem, w_ca_q, w_ca_kv, ca_q_norm, ca_k_norm, w_ca_o, g_mlp, w_up, w_down):
    y_prompt = trunk(x_prompt, mem_prompt, g_mix, w_in, conv_w, conv_b, i_bias, f_bias, attn_q_norm, attn_k_norm, out_gain, w_out, g_ca, g_mem, w_ca_q, w_ca_kv, ca_q_norm, ca_k_norm, w_ca_o, g_mlp, w_up, w_down)
    y_sample = trunk(x_sample, mem_sample, g_mix, w_in, conv_w, conv_b, i_bias, f_bias, attn_q_norm, attn_k_norm, out_gain, w_out, g_ca, g_mem, w_ca_q, w_ca_kv, ca_q_norm, ca_k_norm, w_ca_o, g_mlp, w_up, w_down)
    return (y_prompt, y_sample)
```

```cpp
#include <hip/hip_runtime.h>
#include <cstdio>
#include <cstdint>

#ifndef MK_MULTI
#define MK_MULTI 0
#endif

#define LAS __attribute__((address_space(3)))
typedef unsigned short bf16_t;
typedef short bf16x8 __attribute__((ext_vector_type(8)));
typedef short s16x4 __attribute__((ext_vector_type(4)));
typedef float f32x2 __attribute__((ext_vector_type(2)));
typedef float f32x4 __attribute__((ext_vector_type(4)));
typedef float f32x16 __attribute__((ext_vector_type(16)));
typedef unsigned u32x2 __attribute__((ext_vector_type(2)));
typedef unsigned u32x4 __attribute__((ext_vector_type(4)));

constexpr int NTOK = 40960, NPROMPT = 32768, DM = 2048, DEPTH = 4;
constexpr int NIN = 5136, NINP = 5376, LDU = 5120, DFF = 8192, NMEM = 1536;
constexpr int UC_A = 0, UC_CB = 512, UC_CC = 1024, UC_CX = 1536, UC_MQ = 2048, UC_MK = 2560, UC_MV = 3072, UC_MO = 3584, UC_AQ = 4096, UC_AK = 4608, UC_AV = 4864;
constexpr float EPS = 1e-6f;
constexpr float SC128 = 0.088388347648318440f;

constexpr size_t MiB = 1u << 20;
constexpr size_t WS_CTL = 0, CTL_ZERO_BYTES = 1 * MiB;
constexpr size_t WS_TW = 1 * MiB;
constexpr size_t WS_ROPE = 1 * MiB + 128 * 1024;
constexpr size_t WS_CHK = 1 * MiB + 256 * 1024;
constexpr size_t WS_WIN = 2 * MiB, WS_WOUT = 23 * MiB, WS_WCAQ = 31 * MiB, WS_WCAKV = 33 * MiB, WS_WCAO = 37 * MiB, WS_WUP = 39 * MiB, WS_WDOWN = 71 * MiB;
constexpr size_t WS_GATES = 103 * MiB, WS_NLOC = 106 * MiB, WS_GCH = 107 * MiB + 512 * 1024, WS_MEMN = 108 * MiB, WS_KVCA = 114 * MiB;
constexpr size_t WS_H = 118 * MiB, WS_CST = 278 * MiB, WS_BIG = 358 * MiB;
constexpr size_t WS_U = WS_BIG, WS_Y = WS_BIG + 400 * MiB, WS_TP = WS_BIG + 560 * MiB, WS_HID = WS_BIG, WS_QCA = WS_BIG, WS_OCA = WS_BIG + 40 * MiB;
constexpr size_t WS_END = WS_BIG + 640 * MiB;
constexpr int CW_BAR = 4096;

constexpr int LDS_BYTES = 147456;
constexpr int MISC_OFF = 143360;
constexpr int IMG_PITCH = 136;
constexpr int IMG_BYTES = 128 * IMG_PITCH * 2;

__device__ __forceinline__ float bf2f(bf16_t b) { return __uint_as_float(((unsigned)b) << 16); }
__device__ __forceinline__ float bflo(unsigned w) { return __uint_as_float(w << 16); }
__device__ __forceinline__ float bfhi(unsigned w) { return __uint_as_float(w & 0xffff0000u); }
typedef __bf16 bf16v2_ __attribute__((ext_vector_type(2)));
__device__ __forceinline__ unsigned cvtpk(float lo, float hi) { bf16v2_ v; v.x = (__bf16)lo; v.y = (__bf16)hi; return __builtin_bit_cast(unsigned, v); }
__device__ __forceinline__ bf16_t f2bf(float f) { return __builtin_bit_cast(unsigned short, (__bf16)f); }
__device__ __forceinline__ float wave_sum(float v) {
#pragma unroll
    for (int o = 1; o < 64; o <<= 1) v += __shfl_xor(v, o);
    return v;
}
__device__ __forceinline__ float half_sum32(float v) {
#pragma unroll
    for (int o = 1; o < 32; o <<= 1) v += __shfl_xor(v, o);
    return v;
}
__device__ __forceinline__ int crow(int r, int hi) { return (r & 3) + 8 * (r >> 2) + 4 * hi; }
#define LDS_WAIT() asm volatile("s_waitcnt lgkmcnt(0)" ::: "memory")
#define VM_WAIT() asm volatile("s_waitcnt vmcnt(0)" ::: "memory")
#define SBAR() __builtin_amdgcn_sched_barrier(0)
#define MFMA32(a, b, c) __builtin_amdgcn_mfma_f32_32x32x16_bf16((a), (b), (c), 0, 0, 0)

__device__ __forceinline__ void tok_seq(int t, int& seq, int& p, int& S) {
    if (t < NPROMPT) { seq = t >> 14; p = t & 16383; S = 16384; } else { const int v = t - NPROMPT; seq = 2 + (v >> 11); p = v & 2047; S = 2048; }
}
__device__ __forceinline__ int seq_base(int seq) { return seq < 2 ? seq * 16384 : NPROMPT + (seq - 2) * 2048; }

#define XB_TMO      128
#define XB_XCNT(j)  (256  + 64 * (j))
#define XB_XSUB(j)  (1280 + 64 * (j))
#define XB_XGEN(j)  (2304 + 64 * (j))
#define XB_TOP      3328
#define XB_TOPGEN   3392
#define XCD_BAR_WORDS 3456
#define XB_SPIN_CAP (1u << 20)

__device__ __forceinline__ unsigned xb_ld(unsigned* p)              { return __hip_atomic_load(p, __ATOMIC_RELAXED, __HIP_MEMORY_SCOPE_AGENT); }
__device__ __forceinline__ unsigned xb_add(unsigned* p, unsigned v) { return __hip_atomic_fetch_add(p, v, __ATOMIC_RELAXED, __HIP_MEMORY_SCOPE_AGENT); }
__device__ __forceinline__ unsigned xb_xcc_id() { return (unsigned)__builtin_amdgcn_s_getreg((3 << 11) | 20) & 0xFu; }
#define XB_SPIN(cond, bar) do { unsigned _sp = 0; while (cond) { __builtin_amdgcn_s_sleep(1); \
    if ((++_sp & 255u) == 0u) { if (xb_ld(&(bar)[XB_TMO])) break; if (_sp > XB_SPIN_CAP) { atomicAdd(&(bar)[XB_TMO], 1u); break; } } } } while (0)

struct XcdBarrier { unsigned* bar; unsigned x; volatile LAS unsigned* st; };

__device__ __forceinline__ XcdBarrier xcd_barrier_post(unsigned* bar, volatile LAS unsigned* st) {
    XcdBarrier b; b.bar = bar; b.x = xb_xcc_id(); b.st = st;
    if (threadIdx.x == 0) (void)xb_add(&bar[XB_XCNT(b.x)], 1u);
    return b;
}
__device__ __forceinline__ void xcd_barrier_complete(unsigned* bar, unsigned x, unsigned& nloc, unsigned& nx) {
    const unsigned G = gridDim.x * gridDim.y * gridDim.z;
    unsigned sum, cnt, mine, sp = 0u;
    for (;;) {
        sum = 0u; cnt = 0u; mine = 0u;
#pragma unroll
        for (unsigned j = 0; j < 16; ++j) { const unsigned c = xb_ld(&bar[XB_XCNT(j)]); sum += c; cnt += (c > 0u) ? 1u : 0u; mine = (j == x) ? c : mine; }
        if (sum == G) break;
        __builtin_amdgcn_s_sleep(1);
        if ((++sp & 255u) == 0u) { if (xb_ld(&bar[XB_TMO])) break; if (sp > XB_SPIN_CAP) { atomicAdd(&bar[XB_TMO], 1u); break; } }
    }
    nloc = mine > 0u ? mine : 1u; nx = cnt > 0u ? cnt : 1u;
}
__device__ __forceinline__ void xcd_barrier(const XcdBarrier& b) {
    asm volatile("s_waitcnt vmcnt(0)" ::: "memory");
    __syncthreads();
    if (threadIdx.x == 0) {
        unsigned* bar = b.bar;
        __builtin_amdgcn_s_waitcnt(0);
        unsigned nloc = b.st[0], nx = b.st[1];
        if (nloc == 0u) { xcd_barrier_complete(bar, b.x, nloc, nx); b.st[0] = nloc; b.st[1] = nx; }
        const unsigned old = xb_add(&bar[XB_XSUB(b.x)], 1u);
        const unsigned gen = old / nloc;
        if (old + 1u == (gen + 1u) * nloc) {
            __builtin_amdgcn_fence(__ATOMIC_RELEASE, "agent");
            asm volatile("s_waitcnt vmcnt(0)" ::: "memory");
            const unsigned og = xb_add(&bar[XB_TOP], 1u);
            const unsigned tg = og / nx;
            if (og + 1u == (tg + 1u) * nx) xb_add(&bar[XB_TOPGEN], 1u);
            else XB_SPIN(xb_ld(&bar[XB_TOPGEN]) == tg, bar);
            __builtin_amdgcn_fence(__ATOMIC_ACQUIRE, "agent");
            xb_add(&bar[XB_XGEN(b.x)], 1u);
            asm volatile("s_waitcnt vmcnt(0)" ::: "memory");
        } else {
            XB_SPIN(xb_ld(&bar[XB_XGEN(b.x)]) == gen, bar);
            __builtin_amdgcn_fence(__ATOMIC_ACQUIRE, "agent");
            asm volatile("s_waitcnt vmcnt(0)" ::: "memory");
        }
    }
    __syncthreads();
}

namespace pg8 {
constexpr int BM = 256, BK = 64, HALF = 128, HTB = HALF * BK * 2, STAGE_BYTES = 8 * HTB, NXCD = 8, WGM = 8;
__host__ __device__ __forceinline__ int lds_byte(int r, int c) { const int st = (r >> 4) * 2 + (c >> 5), rr = r & 15, cc = c & 31, ob = rr * 64 + cc * 2; return st * 1024 + (ob ^ (((ob >> 9) & 1) << 5)); }
__host__ __device__ __forceinline__ void stage_rc(int b, int& R, int& C) { const int st = b / 1024, sb = b % 1024, swz = sb ^ (((sb >> 9) & 1) << 5); R = (st >> 1) * 16 + swz / 64; C = (st & 1) * 32 + (swz % 64) / 2; }
__host__ __device__ __forceinline__ int perm32(int rho) { const int n = rho >> 4, i = rho & 15; return 8 * (i >> 2) + 4 * n + (i & 3); }
struct Unit { int pm, pn; };
struct Gemm { const bf16_t* A; const bf16_t* Bt; int M, N, K; };
struct StaticOrder {
    int nM, nN, nwg, G, c;
    __host__ __device__ void init(int M, int N, int G_, int c_) { nM = M / BM; nN = N / BM; nwg = nM * nN; G = G_; c = c_; }
    __host__ __device__ bool next(int i, Unit& u) const {
        const long L = (long)i * G + c; if (L >= nwg) return false;
        int wgid = (int)L; { const int q = nwg / NXCD, r = nwg % NXCD, xcd = wgid % NXCD, off = wgid / NXCD; wgid = (xcd < r ? xcd * (q + 1) : r * (q + 1) + (xcd - r) * q) + off; }
        const int nig = WGM * nN, gid = wgid / nig, fm = gid * WGM, gsz = (nM - fm) < WGM ? (nM - fm) : WGM;
        u.pm = fm + ((wgid % nig) % gsz); u.pn = (wgid % nig) / gsz; return true;
    }
    __device__ __forceinline__ void a_ready(const Unit&) const {}
    __device__ __forceinline__ void done(const Unit&) const {}
};

struct EpiU {
    static constexpr bool PERM = true;
    bf16_t* U; float* gates;
    __device__ __forceinline__ void operator()(const f32x4 (&acc)[2][2][4][2], const Unit& u, int wr, int wc, int fr, int fq) const {
        const int row0 = u.pm * BM + wr * 64 + fr;
        if (u.pn < 20) {
            const int col0 = u.pn * BM + wc * 32 + 8 * fq;
#pragma unroll
            for (int ai = 0; ai < 2; ++ai)
#pragma unroll
                for (int m = 0; m < 4; ++m) { bf16_t* rowp = U + (size_t)(row0 + ai * HALF + m * 16) * LDU + col0;
#pragma unroll
                    for (int bj = 0; bj < 2; ++bj) { const f32x4 v0 = acc[ai][bj][m][0], v1 = acc[ai][bj][m][1];
                        u32x4 w; w.x = cvtpk(v0[0], v0[1]); w.y = cvtpk(v0[2], v0[3]); w.z = cvtpk(v1[0], v1[1]); w.w = cvtpk(v1[2], v1[3]);
                        *(u32x4*)(rowp + bj * HALF) = w; } }
        } else if (wc == 0 && fq < 2) {
#pragma unroll
            for (int ai = 0; ai < 2; ++ai)
#pragma unroll
                for (int m = 0; m < 4; ++m) { float* gp = gates + (size_t)(row0 + ai * HALF + m * 16) * 16 + 8 * fq;
#pragma unroll
                    for (int n = 0; n < 2; ++n) *(f32x4*)(gp + 4 * n) = acc[ai][0][m][n]; }
        }
    }
};
template <int ACT> struct EpiBf {
    static constexpr bool PERM = true;
    bf16_t* O; int ldc;
    __device__ __forceinline__ void operator()(const f32x4 (&acc)[2][2][4][2], const Unit& u, int wr, int wc, int fr, int fq) const {
        const int row0 = u.pm * BM + wr * 64 + fr, col0 = u.pn * BM + wc * 32 + 8 * fq;
#pragma unroll
        for (int ai = 0; ai < 2; ++ai)
#pragma unroll
            for (int m = 0; m < 4; ++m) { bf16_t* rowp = O + (size_t)(row0 + ai * HALF + m * 16) * ldc + col0;
#pragma unroll
                for (int bj = 0; bj < 2; ++bj) { f32x4 v0 = acc[ai][bj][m][0], v1 = acc[ai][bj][m][1];
                    if (ACT == 1) {
#pragma unroll
                        for (int j = 0; j < 4; ++j) { const float a = fmaxf(v0[j], 0.f), b = fmaxf(v1[j], 0.f); v0[j] = a * a; v1[j] = b * b; } }
                    u32x4 w; w.x = cvtpk(v0[0], v0[1]); w.y = cvtpk(v0[2], v0[3]); w.z = cvtpk(v1[0], v1[1]); w.w = cvtpk(v1[2], v1[3]);
                    *(u32x4*)(rowp + bj * HALF) = w; } }
    }
};
struct EpiRes {
    static constexpr bool PERM = false;
    const float* src_lo; const float* src_hi; float* out;
    __device__ __forceinline__ void operator()(const f32x4 (&acc)[2][2][4][2], const Unit& u, int wr, int wc, int fr, int fq) const {
        const int row0 = u.pm * BM + wr * 64 + fr, col0 = u.pn * BM + wc * 32 + 4 * fq;
        const float* src = (u.pm * BM < NPROMPT) ? src_lo : src_hi;
#pragma unroll
        for (int ai = 0; ai < 2; ++ai) {
            f32x4 bs[4][2][2];
#pragma unroll
            for (int m = 0; m < 4; ++m) { const size_t off = (size_t)(row0 + ai * HALF + m * 16) * DM + col0;
#pragma unroll
                for (int bj = 0; bj < 2; ++bj)
#pragma unroll
                    for (int n = 0; n < 2; ++n) bs[m][bj][n] = *(const f32x4*)(src + off + bj * HALF + n * 16); }
#pragma unroll
            for (int m = 0; m < 4; ++m) { const size_t off = (size_t)(row0 + ai * HALF + m * 16) * DM + col0;
#pragma unroll
                for (int bj = 0; bj < 2; ++bj)
#pragma unroll
                    for (int n = 0; n < 2; ++n) *(f32x4*)(out + off + bj * HALF + n * 16) = bs[m][bj][n] + acc[ai][bj][m][n]; }
        }
    }
};

template <class Epi, class Sched>
__device__ __forceinline__ void gemm_phase(LAS unsigned char* lds, const Gemm g, const Sched& S, const Epi& E) {
    int tid_ = threadIdx.x; asm volatile("" : "+v"(tid_));
    const int tid = tid_, wid = __builtin_amdgcn_readfirstlane(tid >> 6), lane = tid & 63, wr = wid >> 2, wc = wid & 3, fr = lane & 15, fq = lane >> 4;
    const int K = g.K, nt = K / BK;
    unsigned voffA[2], voffB[2];
#pragma unroll
    for (int i = 0; i < 2; ++i) { int R, C; stage_rc(tid * 16 + i * 8192, R, C); const int Rb = Epi::PERM ? ((R & ~31) + perm32(R & 31)) : R;
        voffA[i] = (unsigned)(R * K + C) * 2u; voffB[i] = (unsigned)(Rb * K + C) * 2u; }
    const size_t kstep = (size_t)(BK * 2);
    const size_t hstep = (size_t)HALF * K * 2;
    const size_t tstep = 2 * hstep;
    const unsigned ldsw = (unsigned)wid * 1024u;
    const int aoff = lds_byte(wr * 64 + fr, fq * 8), boff = lds_byte(wc * 32 + fr, fq * 8);
#define PG8_SA(b, h) (((b) * 2 + (h)) * HTB)
#define PG8_SB(b, h) ((4 + (b) * 2 + (h)) * HTB)
#define PG8_STAGE(bufoff, gbase, voff) do { _Pragma("unroll") for (int _i = 0; _i < 2; ++_i) \
        __builtin_amdgcn_global_load_lds((const unsigned*)((const char*)(gbase) + (voff)[_i]), (LAS unsigned*)(lds + (bufoff) + ldsw + _i * 8192), 16, 0, 0); } while (0)
#define PG8_LDA(dst, b, h) do { _Pragma("unroll") for (int m = 0; m < 4; ++m) _Pragma("unroll") for (int k = 0; k < 2; ++k) dst[m][k] = *(const LAS bf16x8*)(lds + PG8_SA(b, h) + aoff + m * 2048 + k * 1024); } while (0)
#define PG8_LDB(dst, b, h) do { _Pragma("unroll") for (int n = 0; n < 2; ++n) _Pragma("unroll") for (int k = 0; k < 2; ++k) dst[n][k] = *(const LAS bf16x8*)(lds + PG8_SB(b, h) + boff + n * 2048 + k * 1024); } while (0)
#define PG8_MMA(ai, bj, At, Bt) do { __builtin_amdgcn_s_setprio(1); _Pragma("unroll") for (int m = 0; m < 4; ++m) _Pragma("unroll") for (int n = 0; n < 2; ++n) _Pragma("unroll") for (int k = 0; k < 2; ++k) \
        acc[ai][bj][m][n] = __builtin_amdgcn_mfma_f32_16x16x32_bf16(Bt[n][k], At[m][k], acc[ai][bj][m][n], 0, 0, 0); __builtin_amdgcn_s_setprio(0); } while (0)
#define PG8_WAIT_V(n) asm volatile("s_waitcnt vmcnt(" #n ")" ::: "memory")
#define PG8_WAIT_L(n) asm volatile("s_waitcnt lgkmcnt(" #n ")" ::: "memory")
#define PG8_BAR __builtin_amdgcn_s_barrier()
#define PG8_SCHED __builtin_amdgcn_sched_barrier(0)
    Unit cur, nxt; int ui = 0;
    if (!S.next(0, cur)) return;
    f32x4 acc[2][2][4][2];
#pragma unroll
    for (int a = 0; a < 2; ++a)
#pragma unroll
        for (int b = 0; b < 2; ++b)
#pragma unroll
            for (int m = 0; m < 4; ++m)
#pragma unroll
                for (int n = 0; n < 2; ++n) acc[a][b][m][n] = (f32x4){0.f, 0.f, 0.f, 0.f};
    bf16x8 At[4][2], B0[2][2], B1[2][2];
    const char* cA = (const char*)g.A + (size_t)cur.pm * tstep; const char* cB = (const char*)g.Bt + (size_t)cur.pn * tstep;
    S.a_ready(cur);
    PG8_STAGE(PG8_SB(0, 0), cB, voffB); PG8_STAGE(PG8_SA(0, 0), cA, voffA); PG8_STAGE(PG8_SB(0, 1), cB + hstep, voffB); PG8_STAGE(PG8_SA(0, 1), cA + hstep, voffA);
    if (wr == 1) PG8_BAR;
    PG8_WAIT_V(4); PG8_BAR;
    PG8_STAGE(PG8_SB(1, 0), cB + kstep, voffB); PG8_STAGE(PG8_SA(1, 0), cA + kstep, voffA); PG8_STAGE(PG8_SB(1, 1), cB + hstep + kstep, voffB);
    PG8_WAIT_V(6); PG8_BAR;
    for (;;) {
        const bool has_next = S.next(ui + 1, nxt);
        const char* nA = has_next ? (const char*)g.A + (size_t)nxt.pm * tstep : cA; const char* nB = has_next ? (const char*)g.Bt + (size_t)nxt.pn * tstep : cB;
        for (int t = 0; t < nt; t += 2) {
            const bool last = (t == nt - 2);
            const char* a1 = cA + (size_t)(t + 1) * kstep;
            const char* a2 = last ? nA : cA + (size_t)(t + 2) * kstep; const char* b2 = last ? nB : cB + (size_t)(t + 2) * kstep;
            const char* a3 = a2 + kstep; const char* b3 = b2 + kstep;
            if (last && has_next) S.a_ready(nxt);
            PG8_LDB(B0, 0, 0); PG8_SCHED; PG8_LDA(At, 0, 0); PG8_STAGE(PG8_SA(1, 1), a1 + hstep, voffA);
            PG8_WAIT_L(8); PG8_BAR; PG8_WAIT_L(0); PG8_MMA(0, 0, At, B0); PG8_BAR; PG8_SCHED;
            PG8_LDB(B1, 0, 1); PG8_STAGE(PG8_SB(0, 0), b2, voffB);
            PG8_BAR; PG8_WAIT_L(0); PG8_MMA(0, 1, At, B1); PG8_BAR;
            PG8_LDA(At, 0, 1); PG8_STAGE(PG8_SA(0, 0), a2, voffA);
            PG8_BAR; PG8_WAIT_L(0); PG8_MMA(1, 0, At, B0); PG8_BAR; PG8_SCHED;
            PG8_STAGE(PG8_SB(0, 1), b2 + hstep, voffB);
            PG8_WAIT_V(6); PG8_BAR; PG8_MMA(1, 1, At, B1); PG8_BAR;
            PG8_LDB(B0, 1, 0); PG8_SCHED; PG8_LDA(At, 1, 0); PG8_STAGE(PG8_SA(0, 1), a2 + hstep, voffA);
            PG8_WAIT_L(8); PG8_BAR; PG8_WAIT_L(0); PG8_MMA(0, 0, At, B0); PG8_BAR; PG8_SCHED;
            PG8_LDB(B1, 1, 1); PG8_STAGE(PG8_SB(1, 0), b3, voffB);
            PG8_BAR; PG8_WAIT_L(0); PG8_MMA(0, 1, At, B1); PG8_BAR;
            PG8_LDA(At, 1, 1); PG8_STAGE(PG8_SA(1, 0), a3, voffA);
            PG8_BAR; PG8_WAIT_L(0); PG8_MMA(1, 0, At, B0); PG8_BAR; PG8_SCHED;
            PG8_STAGE(PG8_SB(1, 1), b3 + hstep, voffB);
            PG8_WAIT_V(6); PG8_BAR; PG8_MMA(1, 1, At, B1); PG8_BAR;
        }
        E(acc, cur, wr, wc, fr, fq); S.done(cur);
        if (!has_next) break;
#pragma unroll
        for (int a = 0; a < 2; ++a)
#pragma unroll
            for (int b = 0; b < 2; ++b)
#pragma unroll
                for (int m = 0; m < 4; ++m)
#pragma unroll
                    for (int n = 0; n < 2; ++n) acc[a][b][m][n] = (f32x4){0.f, 0.f, 0.f, 0.f};
        cur = nxt; cA = nA; cB = nB; ++ui;
    }
    PG8_WAIT_V(0);
    if (wr == 0) PG8_BAR;
    PG8_BAR;
#undef PG8_SA
#undef PG8_SB
#undef PG8_STAGE
#undef PG8_LDA
#undef PG8_LDB
#undef PG8_MMA
#undef PG8_WAIT_V
#undef PG8_WAIT_L
#undef PG8_BAR
#undef PG8_SCHED
}
}

namespace att {
constexpr int D = 128, NW = 8, QBLK = 32, KVBLK = 64;
constexpr float SCALE = SC128;
constexpr float THR = 8.f;
constexpr size_t SHM_V = KVBLK * D * 2, SHM_K = KVBLK * D * 2, SHM_ATTN = 2 * SHM_V + 2 * SHM_K + NW * 64 * 4;
#define KSWZ(row, colB) ((row) * 256 + ((colB) ^ (((row) & 7) << 4)))
__device__ __forceinline__ void partialSM(f32x16& p0, f32x16& p1, float& m_reg, float& mn, float& alpha) {
  constexpr float C = SCALE * 1.4426950408889634f;
  float pmax = p0[0]; for (int r = 1; r < 16; ++r) pmax = fmaxf(pmax, p0[r]); for (int r = 0; r < 16; ++r) pmax = fmaxf(pmax, p1[r]);
  { auto rr = __builtin_amdgcn_permlane32_swap(__float_as_uint(pmax), __float_as_uint(pmax), false, false);
    pmax = fmaxf(__uint_as_float(rr[0]), __uint_as_float(rr[1])); }
  if (__builtin_expect(__all(pmax - m_reg <= THR / SCALE), 1)) { mn = m_reg; alpha = 1.f; }
  else { mn = fmaxf(m_reg, pmax); alpha = __builtin_amdgcn_exp2f((m_reg - mn) * C); m_reg = mn; }
  float mnC = -mn * C;
  for (int r = 0; r < 16; ++r) p0[r] = fmaf(p0[r], C, mnC); for (int r = 0; r < 16; ++r) p1[r] = fmaf(p1[r], C, mnC);
  for (int r = 0; r < 16; ++r) p0[r] = __builtin_amdgcn_exp2f(p0[r]);
}
#define PK4(P, BASE, OUT) do { unsigned a0 = cvtpk(P[BASE + 0], P[BASE + 1]), a1 = cvtpk(P[BASE + 2], P[BASE + 3]);   \
    unsigned b0 = cvtpk(P[BASE + 4], P[BASE + 5]), b1 = cvtpk(P[BASE + 6], P[BASE + 7]);                              \
    auto r0 = __builtin_amdgcn_permlane32_swap(a0, b0, false, false); auto r1 = __builtin_amdgcn_permlane32_swap(a1, b1, false, false); \
    u32x4 w = {r0[0], r1[0], r0[1], r1[1]}; OUT = *reinterpret_cast<bf16x8*>(&w); } while (0)
__device__ __forceinline__ void finishSM(f32x16& p0, f32x16& p1, float alpha, float& l_reg, bf16x8& pa0, bf16x8& pa1, bf16x8& pa2, bf16x8& pa3) {
  for (int r = 0; r < 16; ++r) p1[r] = __builtin_amdgcn_exp2f(p1[r]);
  float ps = 0; for (int r = 0; r < 16; ++r) ps += p0[r]; for (int r = 0; r < 16; ++r) ps += p1[r];
  { auto rr = __builtin_amdgcn_permlane32_swap(__float_as_uint(ps), __float_as_uint(ps), false, false);
    ps = __uint_as_float(rr[0]) + __uint_as_float(rr[1]); }
  l_reg = l_reg * alpha + ps;
  PK4(p0, 0, pa0); PK4(p0, 8, pa1); PK4(p1, 0, pa2); PK4(p1, 8, pa3);
}
__device__ __forceinline__ void qkt(f32x16& p0, f32x16& p1, const bf16_t* Ks, const bf16x8* qr, int r32, int hi) {
  p0 = f32x16{}; p1 = f32x16{};
  for (int d0 = 0; d0 < 8; ++d0) { int cb = (d0 * 16 + hi * 8) * 2;
    bf16x8 b0 = *reinterpret_cast<const bf16x8*>((const char*)Ks + KSWZ(r32, cb));
    bf16x8 b1 = *reinterpret_cast<const bf16x8*>((const char*)Ks + KSWZ(32 + r32, cb));
    p0 = MFMA32(b0, qr[d0], p0);
    p1 = MFMA32(b1, qr[d0], p1); }
}
__device__ __forceinline__ int v_st(int k, int c) { const int kk = (k & ~0xC) | ((k & 4) << 1) | ((k & 8) >> 1); return ((kk >> 3) * 4 + (c >> 5)) * 512 + ((kk & 7) * 32 + (c & 31)) * 2; }
__device__ __forceinline__ int v_rd_base(int lane) { return ((lane & 3) << 3) | (((lane >> 2) & 3) << 6) | (((lane >> 4) & 1) << 5) | (((lane >> 5) & 1) << 8); }
constexpr int v_rd_off(int d0, int ks, int half) { return d0 * 512 + ks * 4096 + half * 2048; }
template <int OFF> __device__ __forceinline__ s16x4 tr_read(int vb) {
  s16x4 r; asm volatile("ds_read_b64_tr_b16 %0, %1 offset:%2" : "=&v"(r) : "v"(vb), "i"(OFF) : "memory"); return r;
}
template <int D0> __device__ __forceinline__ void pv_one(f32x16& od, int vb, bf16x8 pa0, bf16x8 pa1, bf16x8 pa2, bf16x8 pa3) {
  const s16x4 l0 = tr_read<v_rd_off(D0, 0, 0)>(vb), h0 = tr_read<v_rd_off(D0, 0, 1)>(vb), l1 = tr_read<v_rd_off(D0, 1, 0)>(vb), h1 = tr_read<v_rd_off(D0, 1, 1)>(vb);
  const s16x4 l2 = tr_read<v_rd_off(D0, 2, 0)>(vb), h2 = tr_read<v_rd_off(D0, 2, 1)>(vb), l3 = tr_read<v_rd_off(D0, 3, 0)>(vb), h3 = tr_read<v_rd_off(D0, 3, 1)>(vb);
  asm volatile("s_waitcnt lgkmcnt(0)" ::: "memory"); SBAR();
#define PKV(L, H) (bf16x8){L[0], L[1], L[2], L[3], H[0], H[1], H[2], H[3]}
  od = MFMA32(pa0, PKV(l0, h0), od);
  od = MFMA32(pa1, PKV(l1, h1), od);
  od = MFMA32(pa2, PKV(l2, h2), od);
  od = MFMA32(pa3, PKV(l3, h3), od);
#undef PKV
}
__device__ __forceinline__ void pv_d0(f32x16* o, int vb, bf16x8 pa0, bf16x8 pa1, bf16x8 pa2, bf16x8 pa3) {
  pv_one<0>(o[0], vb, pa0, pa1, pa2, pa3); pv_one<1>(o[1], vb, pa0, pa1, pa2, pa3); pv_one<2>(o[2], vb, pa0, pa1, pa2, pa3); pv_one<3>(o[3], vb, pa0, pa1, pa2, pa3);
}
template <int MODE, int ldq, int ldk, int ldv, int ldo, int SDEPTH = 1>
__device__ __forceinline__ void attn_body(const bf16_t* __restrict__ Qb, const bf16_t* __restrict__ Kh, const bf16_t* __restrict__ Vh,
                                          bf16_t* __restrict__ Ob, const float* __restrict__ gain, int seq, char* lds) {
  int tid_ = threadIdx.x; asm volatile("" : "+v"(tid_));
  const int tid = tid_, wid = tid >> 6, lane = tid & 63, r32 = lane & 31, hi = lane >> 5;
  bf16_t* V_lds = (bf16_t*)lds; bf16_t* K_lds = (bf16_t*)(lds + 2 * SHM_V);
  float* ws = (float*)(lds + 2 * SHM_V + 2 * SHM_K) + wid * 64; float* li_l = ws; float* al_l = ws + 32;
  float m_reg = -1e30f, l_reg = 0; f32x16 o[4] = {}; bf16x8 qr[8];
  const bf16_t* Qw = Qb + (long)(wid * QBLK + r32) * ldq + hi * 8;
#pragma unroll
  for (int d0 = 0; d0 < 8; ++d0) qr[d0] = *reinterpret_cast<const bf16x8*>(Qw + d0 * 16);
  if (MODE == 1) {
    float ss = 0.f;
#pragma unroll
    for (int d0 = 0; d0 < 8; ++d0)
#pragma unroll
      for (int e = 0; e < 8; ++e) { const float x = bf2f((bf16_t)qr[d0][e]); ss += x * x; }
    ss += __shfl_xor(ss, 32);
    const float rn = rsqrtf(ss * (1.f / 128.f) + EPS);
#pragma unroll
    for (int d0 = 0; d0 < 8; ++d0) { const float* gp = gain + d0 * 16 + hi * 8; u32x4 w;
      w.x = cvtpk(bf2f((bf16_t)qr[d0][0]) * rn * gp[0], bf2f((bf16_t)qr[d0][1]) * rn * gp[1]); w.y = cvtpk(bf2f((bf16_t)qr[d0][2]) * rn * gp[2], bf2f((bf16_t)qr[d0][3]) * rn * gp[3]);
      w.z = cvtpk(bf2f((bf16_t)qr[d0][4]) * rn * gp[4], bf2f((bf16_t)qr[d0][5]) * rn * gp[5]); w.w = cvtpk(bf2f((bf16_t)qr[d0][6]) * rn * gp[6], bf2f((bf16_t)qr[d0][7]) * rn * gp[7]);
      qr[d0] = *reinterpret_cast<bf16x8*>(&w); }
  }
  const int sr = tid >> 4, sc = (tid & 15) * 8, vst0 = v_st(sr, sc), vst1 = v_st(32 + sr, sc);
  const int vb0 = (int)(uintptr_t)V_lds + v_rd_base(lane);
  struct { bf16x8 vs0, vs1, ks0, ks1; } sr_[SDEPTH];
  const unsigned voffv = (unsigned)(sr * ldv + sc), voffk = (unsigned)(sr * ldk + sc);
#define SLOAD(i, k0) do { const bf16_t* vt_ = Vh + (size_t)(k0) * ldv; const bf16_t* kt_ = Kh + (size_t)(k0) * ldk; \
    sr_[i].vs0 = *reinterpret_cast<const bf16x8*>(vt_ + voffv); sr_[i].vs1 = *reinterpret_cast<const bf16x8*>(vt_ + voffv + 32u * ldv); \
    sr_[i].ks0 = *reinterpret_cast<const bf16x8*>(kt_ + voffk); sr_[i].ks1 = *reinterpret_cast<const bf16x8*>(kt_ + voffk + 32u * ldk); } while (0)
#define SWRITE(b, i) do { *(bf16x8*)((char*)V_lds + (b) * SHM_V + vst0) = sr_[i].vs0;          \
    *(bf16x8*)((char*)V_lds + (b) * SHM_V + vst1) = sr_[i].vs1; int kc = sc * 2;               \
    *(bf16x8*)((char*)K_lds + (b) * SHM_K + KSWZ(sr, kc)) = sr_[i].ks0;                       \
    *(bf16x8*)((char*)K_lds + (b) * SHM_K + KSWZ(32 + sr, kc)) = sr_[i].ks1; } while (0)
#define SWAIT() do { if constexpr (SDEPTH == 2) asm volatile("s_waitcnt vmcnt(4)" ::: "memory"); else asm volatile("s_waitcnt vmcnt(0)" ::: "memory"); } while (0)
#define RESC(a) do { if (__any((a) < 1.f)) { if (hi == 0) al_l[r32] = (a); asm volatile("s_waitcnt lgkmcnt(0)" ::: "memory"); \
    for (int d = 0; d < 4; ++d) for (int r = 0; r < 16; ++r) o[d][r] *= al_l[crow(r, hi)]; } } while (0)
  f32x16 pA0, pA1, pB0, pB1; float mnA, mnB, alA, alB; bf16x8 pa0, pa1, pa2, pa3; const int NT = seq / KVBLK;
  constexpr int SE = 0, SO = SDEPTH - 1;
  SLOAD(SE, 0); asm volatile("s_waitcnt vmcnt(0)" ::: "memory"); SWRITE(0, SE); __syncthreads();
  qkt(pA0, pA1, K_lds, qr, r32, hi); partialSM(pA0, pA1, m_reg, mnA, alA);
  SLOAD(SO, KVBLK); if constexpr (SDEPTH == 2) { if (2 < NT) SLOAD(SE, 2 * KVBLK); }
  SWAIT(); SWRITE(1, SO); __syncthreads();
  for (int j = 1; j + 1 < NT; j += 2) {
    SBAR(); qkt(pB0, pB1, (bf16_t*)((char*)K_lds + SHM_K), qr, r32, hi);
    finishSM(pA0, pA1, alA, l_reg, pa0, pa1, pa2, pa3); SBAR();
    SLOAD(SO, (j + SDEPTH) * KVBLK); SBAR();
    pv_d0(o, vb0, pa0, pa1, pa2, pa3); partialSM(pB0, pB1, m_reg, mnB, alB);
    __syncthreads(); SWAIT(); SWRITE(0, SE);
    RESC(alB); __syncthreads();
    SBAR(); qkt(pA0, pA1, K_lds, qr, r32, hi);
    finishSM(pB0, pB1, alB, l_reg, pa0, pa1, pa2, pa3); SBAR();
    if (SDEPTH == 1 || j + 3 < NT) SLOAD(SE, (j + 1 + SDEPTH) * KVBLK); SBAR();
    pv_d0(o, vb0 + (int)SHM_V, pa0, pa1, pa2, pa3); partialSM(pA0, pA1, m_reg, mnA, alA);
    __syncthreads(); SWAIT(); SWRITE(1, SO);
    RESC(alA); __syncthreads();
  }
  SBAR(); qkt(pB0, pB1, (bf16_t*)((char*)K_lds + SHM_K), qr, r32, hi);
  finishSM(pA0, pA1, alA, l_reg, pa0, pa1, pa2, pa3); SBAR();
  pv_d0(o, vb0, pa0, pa1, pa2, pa3); partialSM(pB0, pB1, m_reg, mnB, alB);
  __syncthreads(); RESC(alB);
  finishSM(pB0, pB1, alB, l_reg, pa0, pa1, pa2, pa3); SBAR();
  pv_d0(o, vb0 + (int)SHM_V, pa0, pa1, pa2, pa3);
  if (hi == 0) li_l[r32] = l_reg; asm volatile("s_waitcnt lgkmcnt(0)" ::: "memory");
  bf16_t* Ow = Ob + (long)(wid * QBLK) * ldo;
  if (MODE == 0) {
    float gd[4];
#pragma unroll
    for (int d0 = 0; d0 < 4; ++d0) gd[d0] = gain[d0 * 32 + r32];
#pragma unroll
    for (int r = 0; r < 16; ++r) { const int orow = crow(r, hi); const float rl = __builtin_amdgcn_rcpf(li_l[orow]);
      float v0 = o[0][r] * rl, v1 = o[1][r] * rl, v2 = o[2][r] * rl, v3 = o[3][r] * rl;
      float ss = half_sum32(v0 * v0 + v1 * v1 + v2 * v2 + v3 * v3);
      const float rn = rsqrtf(ss * (1.f / 128.f) + EPS);
      bf16_t* op = Ow + (long)orow * ldo + r32;
      op[0] = f2bf(v0 * rn * gd[0]); op[32] = f2bf(v1 * rn * gd[1]); op[64] = f2bf(v2 * rn * gd[2]); op[96] = f2bf(v3 * rn * gd[3]); }
  } else {
#pragma unroll
    for (int r = 0; r < 16; ++r) { const int orow = crow(r, hi); const float rl = __builtin_amdgcn_rcpf(li_l[orow]);
      bf16_t* op = Ow + (long)orow * ldo + r32;
      op[0] = f2bf(o[0][r] * rl); op[32] = f2bf(o[1][r] * rl); op[64] = f2bf(o[2][r] * rl); op[96] = f2bf(o[3][r] * rl); }
  }
#undef SLOAD
#undef SWRITE
#undef SWAIT
#undef RESC
}
}

struct Ctx {
    float* out; unsigned char* ws;
    LAS unsigned char* lds; char* ldsg;
    int tid, lane, wave, bid, G;
};
constexpr int MISC_XS = 256, MISC_GA = 1280, MISC_DX = 4352;
static_assert(4 * IMG_BYTES <= 139264 && LDS_BYTES - 139264 >= 8192, "LDS map");
constexpr int MISC_OFF2 = 139264;
__device__ __forceinline__ bf16x8 ldimg(LAS unsigned char* img, int row, int k) { return *(const LAS bf16x8*)(img + row * (IMG_PITCH * 2) + k * 2); }
__device__ __forceinline__ float sigmoidf_(float x) { return 1.f / (1.f + __expf(-x)); }
__device__ __forceinline__ float logsigmoidf_(float x) { return fminf(x, 0.f) - log1pf(__expf(-fabsf(x))); }

__device__ __forceinline__ void transpose_item(const float* W, int ldw, int ncols, bf16_t* WT, int K, int row_off, LAS float* scr, int item, int lane) {
    const int nblk = (ncols + 31) >> 5, kb = item / nblk, nb = item - kb * nblk, k0 = 64 * kb, n0 = 32 * nb;
    const int nn = n0 + (lane & 31); const bool okr = nn < ncols;
#pragma unroll 8
    for (int i = 0; i < 32; ++i) { const int kk = 2 * i + (lane >> 5); scr[kk * 33 + (lane & 31)] = okr ? W[(size_t)(k0 + kk) * ldw + nn] : 0.f; }
    LDS_WAIT(); asm volatile("" ::: "memory");
    const int c = lane & 7;
#pragma unroll
    for (int j = 0; j < 4; ++j) { const int n = (lane >> 3) + 8 * j; const LAS float* s = scr + (8 * c) * 33 + n;
        u32x4 o; o.x = cvtpk(s[0 * 33], s[1 * 33]); o.y = cvtpk(s[2 * 33], s[3 * 33]); o.z = cvtpk(s[4 * 33], s[5 * 33]); o.w = cvtpk(s[6 * 33], s[7 * 33]);
        if (n0 + n < ncols) *(u32x4*)(WT + (size_t)(row_off + n0 + n) * K + k0 + 8 * c) = o; }
    LDS_WAIT(); asm volatile("" ::: "memory");
}
__device__ __forceinline__ void rms_row(const float* xrow, const float* g, bf16_t* orow, int lane) {
    const f32x4* xr = (const f32x4*)xrow + lane; f32x4 v[8]; float s = 0.f;
#pragma unroll
    for (int j = 0; j < 8; ++j) { v[j] = xr[64 * j]; s += (v[j].x * v[j].x + v[j].y * v[j].y) + (v[j].z * v[j].z + v[j].w * v[j].w); }
    const float r = rsqrtf(wave_sum(s) * (1.f / DM) + EPS);
    const f32x4* gr = (const f32x4*)g + lane; u32x2* o8 = (u32x2*)orow + lane;
#pragma unroll
    for (int j = 0; j < 8; ++j) { const f32x4 gg = gr[64 * j]; u32x2 w; w.x = cvtpk(v[j].x * r * gg.x, v[j].y * r * gg.y); w.y = cvtpk(v[j].z * r * gg.z, v[j].w * r * gg.w); o8[64 * j] = w; }
}
__device__ __forceinline__ const float* x_row(const float* xp, const float* xs, float* out, int l, int m) {
    return l == 0 ? (m < NPROMPT ? xp + (size_t)m * DM : xs + (size_t)(m - NPROMPT) * DM) : out + (size_t)m * DM;
}
struct Args;
template <class A> __device__ __forceinline__ void p0_prep(Ctx& F, const A& a, int l) {
    unsigned char* ws = F.ws;
    const int gw = F.bid * 8 + F.wave, NGW = F.G * 8, gt = F.bid * 512 + F.tid, NT = F.G * 512;
    if (l == 0) {
        float2* TW = (float2*)(ws + WS_TW); float2* RP = (float2*)(ws + WS_ROPE);
        for (int m = gt; m < 16384; m += NT) { float s, c; sincospif((float)m * (1.f / 8192.f), &s, &c); TW[m] = make_float2(c, s); }
        for (int i = gt; i < 8192; i += NT) { const int pos = i >> 5, f = i & 31; const float inv = powf(10000.f, -(float)f * (1.f / 32.f)); float s, c; sincosf((float)pos * inv, &s, &c); RP[i] = make_float2(c, s); }
    }
    LAS float* scr = (LAS float*)(F.lds + F.wave * 16384);
    const float* w_in = a.in[5] + (size_t)l * DM * NIN; const float* w_out = a.in[13] + (size_t)l * DM * DM; const float* w_caq = a.in[16] + (size_t)l * DM * 512;
    const float* w_cakv = a.in[17] + (size_t)l * DM * 1024; const float* w_cao = a.in[20] + (size_t)l * 512 * DM; const float* w_up = a.in[22] + (size_t)l * DM * DFF; const float* w_down = a.in[23] + (size_t)l * DFF * DM;
    bf16_t* WIN = (bf16_t*)(ws + WS_WIN);
    constexpr int I_A = 32 * 128, I_B = 32 * 32, I_C = 32 * 1, I_O = 32 * 64, I_Q = 32 * 16, I_KV = 32 * 32, I_CO = 8 * 64, I_UP = 32 * 256, I_DN = 128 * 64;
    constexpr int NITEMS = I_A + I_B + I_C + I_O + I_Q + I_KV + I_CO + I_UP + I_DN;
    for (int it = gw; it < NITEMS; it += NGW) {
        int r = it;
        if (r < I_A) { transpose_item(w_in, NIN, 4096, WIN, DM, 0, scr, r, F.lane); continue; } r -= I_A;
        if (r < I_B) { transpose_item(w_in + 4112, NIN, 1024, WIN, DM, 4096, scr, r, F.lane); continue; } r -= I_B;
        if (r < I_C) { transpose_item(w_in + 4096, NIN, 16, WIN, DM, 5120, scr, r, F.lane); continue; } r -= I_C;
        if (r < I_O) { transpose_item(w_out, DM, DM, (bf16_t*)(ws + WS_WOUT), DM, 0, scr, r, F.lane); continue; } r -= I_O;
        if (r < I_Q) { transpose_item(w_caq, 512, 512, (bf16_t*)(ws + WS_WCAQ), DM, 0, scr, r, F.lane); continue; } r -= I_Q;
        if (r < I_KV) { transpose_item(w_cakv, 1024, 1024, (bf16_t*)(ws + WS_WCAKV), DM, 0, scr, r, F.lane); continue; } r -= I_KV;
        if (r < I_CO) { transpose_item(w_cao, DM, DM, (bf16_t*)(ws + WS_WCAO), 512, 0, scr, r, F.lane); continue; } r -= I_CO;
        if (r < I_UP) { transpose_item(w_up, DFF, DFF, (bf16_t*)(ws + WS_WUP), DM, 0, scr, r, F.lane); continue; } r -= I_UP;
        transpose_item(w_down, DM, DM, (bf16_t*)(ws + WS_WDOWN), DFF, 0, scr, r, F.lane);
    }
    { u32x4* z = (u32x4*)(WIN + (size_t)NIN * DM); unsigned z0 = 0u; asm volatile("" : "+v"(z0)); const u32x4 zero = {z0, z0, z0, z0}; for (int i = gt; i < (NINP - NIN) * DM / 8; i += NT) z[i] = zero; }
    bf16_t* H = (bf16_t*)(ws + WS_H); bf16_t* MEMN = (bf16_t*)(ws + WS_MEMN);
    const float* gmix = a.in[4] + (size_t)l * DM; const float* gmem = a.in[15] + (size_t)l * DM;
    for (int m = gw; m < NTOK; m += NGW) rms_row(x_row(a.in[0], a.in[1], F.out, l, m), gmix, H + (size_t)m * DM, F.lane);
    for (int m = gw; m < NMEM; m += NGW) rms_row(m < 512 ? a.in[2] + (size_t)m * DM : a.in[3] + (size_t)(m - 512) * DM, gmem, MEMN + (size_t)m * DM, F.lane);
}
__device__ __forceinline__ void rms_phase(Ctx& F, const float* g) {
    bf16_t* H = (bf16_t*)(F.ws + WS_H); const int gw = F.bid * 8 + F.wave, NGW = F.G * 8;
    for (int m = gw; m < NTOK; m += NGW) rms_row(F.out + (size_t)m * DM, g, H + (size_t)m * DM, F.lane);
}

__device__ __forceinline__ void f1_gen_images(Ctx& F, const float2* TW) {
    LAS bf16_t* CI = (LAS bf16_t*)F.lds; LAS bf16_t* SI = (LAS bf16_t*)(F.lds + IMG_BYTES);
    for (int idx = F.tid; idx < 16384; idx += 512) { const int r = idx >> 7, c = idx & 127; const float2 w = TW[((r * c) & 127) * 128]; CI[r * IMG_PITCH + c] = f2bf(w.x); SI[r * IMG_PITCH + c] = f2bf(w.y); }
}
__device__ __forceinline__ void f1_unit(Ctx& F, int uidx, const bf16_t* U, bf16_t* TP, const float2* TW) {
    int seq, g, s2, N2;
    if (uidx < 1024) { seq = uidx >> 9; g = (uidx >> 7) & 3; s2 = uidx & 127; N2 = 128; } else { const int v = uidx - 1024; seq = 2 + (v >> 6); g = (v >> 4) & 3; s2 = v & 15; N2 = 16; }
    const int base = seq_base(seq), S = 128 * N2;
    LAS unsigned char* CI = F.lds; LAS unsigned char* SI = F.lds + IMG_BYTES; LAS unsigned char* GR = F.lds + 2 * IMG_BYTES; LAS unsigned char* HI = F.lds + 3 * IMG_BYTES;
    const int rb = F.wave & 3, ch = F.wave >> 2, i32 = F.lane & 31, hi = F.lane >> 5;
    bf16x8 xf[8];
    { const bf16_t* xp = U + (size_t)(base + N2 * (32 * rb + i32) + s2) * LDU + UC_A + g * 128 + hi * 8;
#pragma unroll
      for (int kb = 0; kb < 8; ++kb) xf[kb] = *(const bf16x8*)(xp + 16 * kb); }
    f32x16 gr[2] = {}, hh[2] = {};
#pragma unroll
    for (int kb = 0; kb < 8; ++kb)
#pragma unroll
        for (int cbl = 0; cbl < 2; ++cbl) { const int jr = 32 * (2 * ch + cbl) + i32;
            gr[cbl] = MFMA32(xf[kb], ldimg(CI, jr, 16 * kb + 8 * hi), gr[cbl]); hh[cbl] = MFMA32(xf[kb], ldimg(SI, jr, 16 * kb + 8 * hi), hh[cbl]); }
#pragma unroll
    for (int cbl = 0; cbl < 2; ++cbl)
#pragma unroll
        for (int q = 0; q < 4; ++q) { const int j = 32 * (2 * ch + cbl) + i32, s1 = 32 * rb + 8 * q + 4 * hi;
            u32x2 w; w.x = cvtpk(gr[cbl][4 * q], gr[cbl][4 * q + 1]); w.y = cvtpk(gr[cbl][4 * q + 2], gr[cbl][4 * q + 3]); *(LAS u32x2*)(GR + j * (IMG_PITCH * 2) + s1 * 2) = w;
            u32x2 x; x.x = cvtpk(hh[cbl][4 * q], hh[cbl][4 * q + 1]); x.y = cvtpk(hh[cbl][4 * q + 2], hh[cbl][4 * q + 3]); *(LAS u32x2*)(HI + j * (IMG_PITCH * 2) + s1 * 2) = x; }
    __syncthreads();
    f32x16 tr[2] = {}, tn[2] = {};
#pragma unroll
    for (int kb = 0; kb < 8; ++kb) { const bf16x8 cf = ldimg(CI, 32 * rb + i32, 16 * kb + 8 * hi), sf = ldimg(SI, 32 * rb + i32, 16 * kb + 8 * hi);
#pragma unroll
        for (int cbl = 0; cbl < 2; ++cbl) { const int jr = 32 * (2 * ch + cbl) + i32; const bf16x8 gf = ldimg(GR, jr, 16 * kb + 8 * hi), hf = ldimg(HI, jr, 16 * kb + 8 * hi); u32x4 nh_ = *reinterpret_cast<const u32x4*>(&hf); nh_ ^= 0x80008000u; const bf16x8 nhf = *reinterpret_cast<const bf16x8*>(&nh_);
            tr[cbl] = MFMA32(cf, gf, tr[cbl]); tr[cbl] = MFMA32(sf, nhf, tr[cbl]); tn[cbl] = MFMA32(cf, hf, tn[cbl]); tn[cbl] = MFMA32(sf, gf, tn[cbl]); } }
    const int mul = 128 / N2;
    bf16_t* tp = TP + (size_t)base * 1024 + (size_t)g * S * 256;
#pragma unroll
    for (int r = 0; r < 16; ++r) { const int k1 = 32 * rb + crow(r, hi); const float2 w = TW[(k1 * s2 * mul) & 16383];
#pragma unroll
        for (int cbl = 0; cbl < 2; ++cbl) { const int j = 32 * (2 * ch + cbl) + i32; const float Tr = tr[cbl][r], Tn = tn[cbl][r];
            tp[((size_t)(k1 * 2 + 0) * N2 + s2) * 128 + j] = f2bf(Tr * w.x - Tn * w.y); tp[((size_t)(k1 * 2 + 1) * N2 + s2) * 128 + j] = f2bf(-Tr * w.y - Tn * w.x); } }
}
__device__ __forceinline__ void f2_gen_images(Ctx& F, int type, const float2* TW) {
    LAS bf16_t* AC = (LAS bf16_t*)F.lds; LAS bf16_t* AS = (LAS bf16_t*)(F.lds + IMG_BYTES);
    for (int idx = F.tid; idx < 16384; idx += 512) { const int rho = idx >> 7, kap = idx & 127; float c = 0.f, s = 0.f;
        if (type == 0) { const float2 w = TW[((rho * kap) & 127) * 128]; c = w.x; s = w.y; }
        else if ((rho >> 4) == (kap >> 4)) { const float2 w = TW[(((rho & 15) * (kap & 15)) & 15) * 1024]; c = w.x; s = w.y; }
        AC[rho * IMG_PITCH + kap] = f2bf(c); AS[rho * IMG_PITCH + kap] = f2bf(s); }
}
__device__ __forceinline__ void f2_unit(Ctx& F, int uidx, const bf16_t* TP, bf16_t* Y, const float* gain, int& img_type, const float2* TW) {
    int seq, g, k10, N2, lg;
    if (uidx < 1024) { seq = uidx >> 9; g = (uidx >> 7) & 3; k10 = uidx & 127; N2 = 128; lg = 7; } else { const int v = uidx - 1024; seq = 2 + (v >> 6); g = (v >> 4) & 3; k10 = (v & 15) * 8; N2 = 16; lg = 4; }
    const int base = seq_base(seq), S = 128 * N2, type = (N2 == 128) ? 0 : 1;
    LAS unsigned char* AC = F.lds; LAS unsigned char* AS = F.lds + IMG_BYTES; LAS unsigned char* TR = F.lds + 2 * IMG_BYTES; LAS unsigned char* TI = F.lds + 3 * IMG_BYTES;
    LAS float* XS = (LAS float*)(F.lds + MISC_OFF2 + MISC_XS);
    __syncthreads();
    if (img_type != type) { f2_gen_images(F, type, TW); img_type = type; }
    const bf16_t* tp = TP + (size_t)base * 1024 + (size_t)g * S * 256;
    { const int kap = F.tid & 127, dg = F.tid >> 7, k1 = k10 + (kap >> lg), s2 = kap & (N2 - 1);
#pragma unroll
      for (int p = 0; p < 2; ++p) { const bf16_t* src = tp + ((size_t)(k1 * 2 + p) * N2 + s2) * 128 + dg * 32; LAS bf16_t* dst = (LAS bf16_t*)(p ? TI : TR);
#pragma unroll
          for (int i = 0; i < 4; ++i) { const bf16x8 v = *(const bf16x8*)(src + 8 * i);
#pragma unroll
              for (int e = 0; e < 8; ++e) dst[(dg * 32 + 8 * i + e) * IMG_PITCH + kap] = (bf16_t)v[e]; } } }
    __syncthreads();
    const int rb = F.wave & 3, ch = F.wave >> 2, i32 = F.lane & 31, hi = F.lane >> 5;
    f32x16 acc[2] = {};
#pragma unroll
    for (int kb = 0; kb < 8; ++kb) { const bf16x8 af = ldimg(AC, 32 * rb + i32, 16 * kb + 8 * hi), sf = ldimg(AS, 32 * rb + i32, 16 * kb + 8 * hi);
#pragma unroll
        for (int cbl = 0; cbl < 2; ++cbl) { const int jr = 32 * (2 * ch + cbl) + i32;
            acc[cbl] = MFMA32(af, ldimg(TR, jr, 16 * kb + 8 * hi), acc[cbl]); acc[cbl] = MFMA32(sf, ldimg(TI, jr, 16 * kb + 8 * hi), acc[cbl]); } }
    const float osc = rsqrtf((float)S * 128.f);
#pragma unroll
    for (int r = 0; r < 16; ++r) { const float v0 = acc[0][r] * osc, v1 = acc[1][r] * osc; acc[0][r] = v0; acc[1][r] = v1;
        const float ss = half_sum32(v0 * v0 + v1 * v1); if (i32 == 0) XS[ch * 128 + 32 * rb + crow(r, hi)] = ss; }
    __syncthreads();
    const float g0 = gain[g * 128 + 32 * (2 * ch) + i32], g1 = gain[g * 128 + 32 * (2 * ch + 1) + i32];
#pragma unroll
    for (int r = 0; r < 16; ++r) { const int row = 32 * rb + crow(r, hi); const float rn = rsqrtf((XS[row] + XS[128 + row]) * (1.f / 128.f) + EPS);
        const int tok = base + k10 + (row >> lg) + 128 * (row & (N2 - 1));
        bf16_t* yp = Y + (size_t)tok * DM + g * 128 + 32 * (2 * ch) + i32;
        yp[0] = f2bf(acc[0][r] * rn * g0); yp[32] = f2bf(acc[1][r] * rn * g1); }
}

__device__ __forceinline__ void conv_job(Ctx& F, int job, const bf16_t* U, bf16_t* Y, const float* cw, const float* cbias, const float* gain) {
    const int c0 = F.lane * 8;
    float w0[8], w1[8], w2[8], bb[8], gg[8];
#pragma unroll
    for (int e = 0; e < 8; ++e) { w0[e] = cw[c0 + e]; w1[e] = cw[512 + c0 + e]; w2[e] = cw[1024 + c0 + e]; bb[e] = cbias[c0 + e]; gg[e] = gain[512 + c0 + e]; }
    for (int it = 0; it < 8; ++it) {
        const int t = job * 64 + F.wave * 8 + it; int seq, p, S; tok_seq(t, seq, p, S);
        const bf16_t* ur = U + (size_t)t * LDU + c0;
        const bf16x8 zero = {0, 0, 0, 0, 0, 0, 0, 0};
        const bf16x8 cb = *(const bf16x8*)(ur + UC_CB), cc0 = *(const bf16x8*)(ur + UC_CC), cx0 = *(const bf16x8*)(ur + UC_CX);
        const bf16x8 ccm = p > 0 ? *(const bf16x8*)(ur - LDU + UC_CC) : zero, cxm = p > 0 ? *(const bf16x8*)(ur - LDU + UC_CX) : zero;
        const bf16x8 ccp = p < S - 1 ? *(const bf16x8*)(ur + LDU + UC_CC) : zero, cxp = p < S - 1 ? *(const bf16x8*)(ur + LDU + UC_CX) : zero;
        float y[8]; float ss = 0.f;
#pragma unroll
        for (int e = 0; e < 8; ++e) { const float zm = bf2f((bf16_t)ccm[e]) * bf2f((bf16_t)cxm[e]), z0 = bf2f((bf16_t)cc0[e]) * bf2f((bf16_t)cx0[e]), zp = bf2f((bf16_t)ccp[e]) * bf2f((bf16_t)cxp[e]);
            y[e] = bf2f((bf16_t)cb[e]) * (w0[e] * zm + w1[e] * z0 + w2[e] * zp + bb[e]); ss += y[e] * y[e]; }
        ss += __shfl_xor(ss, 1); ss += __shfl_xor(ss, 2); ss += __shfl_xor(ss, 4); ss += __shfl_xor(ss, 8);
        const float rn = rsqrtf(ss * (1.f / 128.f) + EPS);
        u32x4 w; w.x = cvtpk(y[0] * rn * gg[0], y[1] * rn * gg[1]); w.y = cvtpk(y[2] * rn * gg[2], y[3] * rn * gg[3]); w.z = cvtpk(y[4] * rn * gg[4], y[5] * rn * gg[5]); w.w = cvtpk(y[6] * rn * gg[6], y[7] * rn * gg[7]);
        *(u32x4*)(Y + (size_t)t * DM + 512 + c0) = w;
    }
}
__device__ __forceinline__ void rope_job(Ctx& F, int job, bf16_t* U, const float* qn, const float* kn, const float2* RP) {
    const int a = F.lane >> 5, f = F.lane & 31, dlo = a * 64 + f, dhi = dlo + 32;
    for (int it = 0; it < 48; ++it) {
        const int item = F.wave * 48 + it, tl = item / 6, hd = item - tl * 6, t = job * 64 + tl; int seq, p, S; tok_seq(t, seq, p, S);
        bf16_t* up = U + (size_t)t * LDU + (hd < 4 ? UC_AQ + hd * 128 : UC_AK + (hd - 4) * 128);
        const float* gn = hd < 4 ? qn : kn;
        float x0 = bf2f(up[dlo]), x1 = bf2f(up[dhi]);
        const float rn = rsqrtf(wave_sum(x0 * x0 + x1 * x1) * (1.f / 128.f) + EPS);
        x0 *= rn * gn[dlo]; x1 *= rn * gn[dhi];
        const int pos = a == 0 ? (p >> 6) : (p & 63); const float2 cs = RP[pos * 32 + f];
        up[dlo] = f2bf(x0 * cs.x - x1 * cs.y); up[dhi] = f2bf(x1 * cs.x + x0 * cs.y);
    }
}
__device__ __forceinline__ void kvnorm_job(Ctx& F, int job, bf16_t* KV, const float* kn) {
    for (int it = 0; it < 64; ++it) { const int id = job * 512 + F.wave * 64 + it, row = id >> 2, hd = id & 3;
        bf16_t* kp = KV + (size_t)row * 1024 + hd * 128;
        float x0 = bf2f(kp[F.lane]), x1 = bf2f(kp[64 + F.lane]);
        const float rn = rsqrtf(wave_sum(x0 * x0 + x1 * x1) * (1.f / 128.f) + EPS);
        kp[F.lane] = f2bf(x0 * rn * kn[F.lane]); kp[64 + F.lane] = f2bf(x1 * rn * kn[64 + F.lane]); }
}

__device__ __forceinline__ void mlstm_gates(Ctx& F, int t0, int h, const float* gates, const float* ib, const float* fb) {
    LAS float* GA = (LAS float*)(F.lds + MISC_OFF2 + MISC_GA);
    if (F.tid < 256) { const int l = F.tid & 127, dir = F.tid >> 7; const float* gp = gates + (size_t)(t0 + l) * 16;
        GA[(2 + dir) * 128 + l] = gp[dir * 4 + h] + ib[dir * 4 + h]; GA[(4 + dir) * 128 + l] = logsigmoidf_(gp[8 + dir * 4 + h] + fb[dir * 4 + h]); }
    __syncthreads();
    if (F.tid < 256) { const int l = F.tid & 127, dir = F.tid >> 7; float s = 0.f;
        if (dir == 0) { for (int r = 0; r <= l; ++r) s += GA[4 * 128 + r]; } else { for (int r = 127; r >= l; --r) s += GA[5 * 128 + r]; }
        GA[dir * 128 + l] = s; }
    __syncthreads();
}
__device__ __forceinline__ void load_tile_T(LAS unsigned char* img, const bf16_t* src, int tid) {
    const int s = tid & 127, dg = tid >> 7; LAS bf16_t* d = (LAS bf16_t*)img; const bf16_t* sp = src + (size_t)s * LDU + dg * 32;
#pragma unroll
    for (int i = 0; i < 4; ++i) { const bf16x8 v = *(const bf16x8*)(sp + 8 * i);
#pragma unroll
        for (int e = 0; e < 8; ++e) d[(dg * 32 + 8 * i + e) * IMG_PITCH + s] = (bf16_t)v[e]; }
}
__device__ __forceinline__ void load_tile_R(LAS unsigned char* img, const bf16_t* src, int tid) {
#pragma unroll
    for (int i = 0; i < 4; ++i) { const int id = tid + 512 * i, row = id >> 4, c = id & 15; *(LAS bf16x8*)(img + row * (IMG_PITCH * 2) + c * 16) = *(const bf16x8*)(src + (size_t)row * LDU + c * 8); }
}
__device__ __forceinline__ void m1_unit(Ctx& F, int uidx, const bf16_t* U, const float* gates, const float* ib, const float* fb, bf16_t* CST, float* NLOC, float* GCH) {
    const int cg = uidx >> 2, h = uidx & 3, t0 = cg * 128;
    LAS unsigned char* VT = F.lds; LAS unsigned char* KE0 = F.lds + IMG_BYTES; LAS unsigned char* KE1 = F.lds + 2 * IMG_BYTES;
    LAS float* GA = (LAS float*)(F.lds + MISC_OFF2 + MISC_GA);
    __syncthreads();
    mlstm_gates(F, t0, h, gates, ib, fb);
    const float tot0 = GA[127], tot1 = GA[128];
    if (F.tid < 2) GCH[(cg * 4 + h) * 2 + F.tid] = F.tid ? tot1 : tot0;
    load_tile_T(VT, U + (size_t)t0 * LDU + UC_MV + h * 128, F.tid);
    { const int s = F.tid & 127, dg = F.tid >> 7; const float e0 = __expf(tot0 - GA[s] + GA[2 * 128 + s]), e1 = __expf(tot1 - GA[128 + s] + GA[3 * 128 + s]);
      const bf16_t* sp = U + (size_t)(t0 + s) * LDU + UC_MK + h * 128 + dg * 32;
#pragma unroll
      for (int i = 0; i < 4; ++i) { const bf16x8 v = *(const bf16x8*)(sp + 8 * i);
#pragma unroll
          for (int e = 0; e < 8; ++e) { const float kf = bf2f((bf16_t)v[e]); ((LAS bf16_t*)KE0)[(dg * 32 + 8 * i + e) * IMG_PITCH + s] = f2bf(kf * e0); ((LAS bf16_t*)KE1)[(dg * 32 + 8 * i + e) * IMG_PITCH + s] = f2bf(kf * e1); } } }
    __syncthreads();
    const int dir = F.wave >> 2, rb = F.wave & 3, i32 = F.lane & 31, hi = F.lane >> 5;
    LAS unsigned char* KE = dir ? KE1 : KE0;
    f32x16 acc[4] = {};
#pragma unroll
    for (int kk = 0; kk < 8; ++kk) { const bf16x8 af = ldimg(VT, 32 * rb + i32, 16 * kk + 8 * hi);
#pragma unroll
        for (int cb = 0; cb < 4; ++cb) acc[cb] = MFMA32(af, ldimg(KE, 32 * cb + i32, 16 * kk + 8 * hi), acc[cb]); }
    const int slot = (cg * 4 + h) * 2 + dir; bf16_t* cst = CST + (size_t)slot * 16384;
#pragma unroll
    for (int r = 0; r < 16; ++r) { const int d2 = 32 * rb + crow(r, hi);
#pragma unroll
        for (int cb = 0; cb < 4; ++cb) cst[d2 * 128 + 32 * cb + i32] = f2bf(acc[cb][r] * SC128); }
    if (F.tid < 256) { const int dr = F.tid >> 7, d1 = F.tid & 127; LAS unsigned char* KS = dr ? KE1 : KE0; float s = 0.f;
#pragma unroll 4
        for (int c = 0; c < 16; ++c) { const bf16x8 v = ldimg(KS, d1, 8 * c);
#pragma unroll
            for (int e = 0; e < 8; ++e) s += bf2f((bf16_t)v[e]); }
        NLOC[(size_t)((cg * 4 + h) * 2 + dr) * 128 + d1] = s * SC128; }
}
__device__ __forceinline__ void m2_scan(Ctx& F, bf16_t* CST, float* NLOC, const float* GCH) {
    const int gt = F.bid * 512 + F.tid, NT = F.G * 512;
    for (int item = gt; item < 48 * 2048; item += NT) {
        const int scan = item >> 11, grp = item & 2047, seq = scan >> 3, h = (scan >> 1) & 3, dir = scan & 1;
        const int nc = seq < 2 ? 128 : 16, cg0 = seq < 2 ? seq * 128 : 256 + (seq - 2) * 16;
        float st[8] = {0.f, 0.f, 0.f, 0.f, 0.f, 0.f, 0.f, 0.f};
#pragma unroll 4
        for (int step = 0; step < nc; ++step) { const int c = dir ? nc - 1 - step : step, slot = ((cg0 + c) * 4 + h) * 2 + dir;
            u32x4* p = (u32x4*)(CST + (size_t)slot * 16384 + grp * 8); const u32x4 v = *p; const float a = __expf(GCH[slot]);
            u32x4 o; o.x = cvtpk(st[0], st[1]); o.y = cvtpk(st[2], st[3]); o.z = cvtpk(st[4], st[5]); o.w = cvtpk(st[6], st[7]); *p = o;
            st[0] = a * st[0] + bflo(v.x); st[1] = a * st[1] + bfhi(v.x); st[2] = a * st[2] + bflo(v.y); st[3] = a * st[3] + bfhi(v.y);
            st[4] = a * st[4] + bflo(v.z); st[5] = a * st[5] + bfhi(v.z); st[6] = a * st[6] + bflo(v.w); st[7] = a * st[7] + bfhi(v.w); }
    }
    for (int item = gt; item < 48 * 128; item += NT) {
        const int scan = item >> 7, d = item & 127, seq = scan >> 3, h = (scan >> 1) & 3, dir = scan & 1;
        const int nc = seq < 2 ? 128 : 16, cg0 = seq < 2 ? seq * 128 : 256 + (seq - 2) * 16;
        float st = 0.f;
        for (int step = 0; step < nc; ++step) { const int c = dir ? nc - 1 - step : step, slot = ((cg0 + c) * 4 + h) * 2 + dir;
            float* p = NLOC + (size_t)slot * 128 + d; const float v = *p; *p = st; st = __expf(GCH[slot]) * st + v; }
    }
}
__device__ __forceinline__ void m3_unit(Ctx& F, int uidx, const bf16_t* U, const float* gates, const float* ib, const float* fb, const bf16_t* CST, const float* NLOC, bf16_t* Y, const float* gain) {
    const int cg = uidx >> 2, h = uidx & 3, t0 = cg * 128;
    LAS unsigned char* VT = F.lds; LAS unsigned char* KR = F.lds + IMG_BYTES; LAS unsigned char* QR = F.lds + 2 * IMG_BYTES;
    LAS float* GA = (LAS float*)(F.lds + MISC_OFF2 + MISC_GA); LAS float* XS = (LAS float*)(F.lds + MISC_OFF2 + MISC_XS); LAS float* DX = (LAS float*)(F.lds + MISC_OFF2 + MISC_DX) + F.wave * 64;
    __syncthreads();
    mlstm_gates(F, t0, h, gates, ib, fb);
    load_tile_T(VT, U + (size_t)t0 * LDU + UC_MV + h * 128, F.tid);
    load_tile_R(KR, U + (size_t)t0 * LDU + UC_MK + h * 128, F.tid);
    load_tile_R(QR, U + (size_t)t0 * LDU + UC_MQ + h * 128, F.tid);
    __syncthreads();
    const int rb = F.wave & 3, ch = F.wave >> 2, i32 = F.lane & 31, hi = F.lane >> 5, l = 32 * rb + i32;
    bf16x8 qf[8];
#pragma unroll
    for (int kb = 0; kb < 8; ++kb) qf[kb] = ldimg(QR, l, 16 * kb + 8 * hi);
    f32x16 acc[2][2] = {}; float den[2] = {0.f, 0.f};
    const float bl0 = GA[l], bl1 = GA[128 + l];
#pragma unroll 1
    for (int sb = 0; sb < 4; ++sb) {
        f32x16 p = {};
#pragma unroll
        for (int kb = 0; kb < 8; ++kb) p = MFMA32(ldimg(KR, 32 * sb + i32, 16 * kb + 8 * hi), qf[kb], p);
#pragma unroll
        for (int dir = 0; dir < 2; ++dir) {
            const bool act = dir == 0 ? (sb <= rb) : (sb >= rb);
            if (act) {
                LAS float* bA = GA + dir * 128; LAS float* liA = GA + (2 + dir) * 128; const float bl = dir ? bl1 : bl0;
                float pm[16];
#pragma unroll
                for (int r = 0; r < 16; ++r) { const int s = 32 * sb + crow(r, hi); const bool ok = dir == 0 ? (s <= l) : (s >= l);
                    const float w = ok ? __expf(bl - bA[s] + liA[s]) : 0.f; pm[r] = p[r] * SC128 * w; den[dir] += pm[r]; }
                bf16x8 pal, pah; PK4(pm, 0, pal); PK4(pm, 8, pah);
#pragma unroll
                for (int cbl = 0; cbl < 2; ++cbl) { const int jr = 32 * (2 * ch + cbl) + i32;
                    acc[dir][cbl] = MFMA32(pal, ldimg(VT, jr, 32 * sb + 8 * hi), acc[dir][cbl]); acc[dir][cbl] = MFMA32(pah, ldimg(VT, jr, 32 * sb + 16 + 8 * hi), acc[dir][cbl]); }
            }
        }
    }
#pragma unroll
    for (int dir = 0; dir < 2; ++dir) {
        den[dir] += __shfl_xor(den[dir], 32);
        const float iw = __expf(dir ? bl1 : bl0); const int slot = (cg * 4 + h) * 2 + dir; const float* np = NLOC + (size_t)slot * 128; const bf16_t* cp = CST + (size_t)slot * 16384;
        float dq = 0.f;
#pragma unroll
        for (int kb = 0; kb < 8; ++kb) { float x[8];
#pragma unroll
            for (int e = 0; e < 8; ++e) { x[e] = bf2f((bf16_t)qf[kb][e]); dq += x[e] * np[16 * kb + 8 * hi + e]; }
            u32x4 w; w.x = cvtpk(x[0] * iw, x[1] * iw); w.y = cvtpk(x[2] * iw, x[3] * iw); w.z = cvtpk(x[4] * iw, x[5] * iw); w.w = cvtpk(x[6] * iw, x[7] * iw); const bf16x8 aq = *reinterpret_cast<bf16x8*>(&w);
#pragma unroll
            for (int cbl = 0; cbl < 2; ++cbl) { const int jr = 32 * (2 * ch + cbl) + i32; acc[dir][cbl] = MFMA32(aq, *(const bf16x8*)(cp + jr * 128 + 16 * kb + 8 * hi), acc[dir][cbl]); } }
        dq += __shfl_xor(dq, 32); den[dir] += iw * dq;
        if (hi == 0) DX[dir * 32 + i32] = den[dir];
    }
    LDS_WAIT(); asm volatile("" ::: "memory");
    f32x16 ht[2];
#pragma unroll
    for (int r = 0; r < 16; ++r) { const float rd0 = 1.f / fmaxf(fabsf(DX[crow(r, hi)]), 1.f), rd1 = 1.f / fmaxf(fabsf(DX[32 + crow(r, hi)]), 1.f);
        ht[0][r] = acc[0][0][r] * rd0 + acc[1][0][r] * rd1; ht[1][r] = acc[0][1][r] * rd0 + acc[1][1][r] * rd1; }
#pragma unroll
    for (int r = 0; r < 16; ++r) { const float ss = half_sum32(ht[0][r] * ht[0][r] + ht[1][r] * ht[1][r]); if (i32 == 0) XS[ch * 128 + 32 * rb + crow(r, hi)] = ss; }
    __syncthreads();
    const int c0 = h * 128 + 32 * (2 * ch) + i32; const float g0 = gain[1024 + c0], g1 = gain[1024 + c0 + 32];
#pragma unroll
    for (int r = 0; r < 16; ++r) { const int row = 32 * rb + crow(r, hi), tok = t0 + row; const float rn = rsqrtf((XS[row] + XS[128 + row]) * (1.f / 128.f) + EPS);
        const bf16_t* mo = U + (size_t)tok * LDU + UC_MO + c0; bf16_t* yp = Y + (size_t)tok * DM + 1024 + c0;
        yp[0] = f2bf(ht[0][r] * rn * sigmoidf_(bf2f(mo[0])) * g0); yp[32] = f2bf(ht[1][r] * rn * sigmoidf_(bf2f(mo[32])) * g1); }
}

constexpr int NPHASE = 13;
struct Args { const float* in[24]; float* out; unsigned char* ws; int layer_lo, layer_hi, ph_lo, ph_hi; };
__global__ void __launch_bounds__(512, 2) fwd(Args a) {
    extern __shared__ __attribute__((aligned(16))) unsigned char lds[];
    Ctx F;
    F.out = a.out; F.ws = a.ws; F.lds = (LAS unsigned char*)lds; F.ldsg = (char*)lds;
    F.tid = threadIdx.x; F.lane = F.tid & 63; F.wave = __builtin_amdgcn_readfirstlane(F.tid >> 6); F.bid = blockIdx.x; F.G = gridDim.x;
    unsigned char* ws = a.ws;
    for (int u = F.tid; u < (LDS_BYTES - MISC_OFF2) / 4; u += 512) ((LAS unsigned*)(F.lds + MISC_OFF2))[u] = 0u;
    __syncthreads();
    XcdBarrier bar; bar.bar = (unsigned*)(ws + WS_CTL) + CW_BAR; bar.x = 0; bar.st = nullptr;
    if (!MK_MULTI) bar = xcd_barrier_post((unsigned*)(ws + WS_CTL) + CW_BAR, (volatile LAS unsigned*)(F.lds + MISC_OFF2));
#define GRID_BAR() do { if (!MK_MULTI) xcd_barrier(bar); } while (0)
#define PHASE_BEGIN() do { int t_ = threadIdx.x; asm volatile("" : "+v"(t_)); F.tid = t_; F.lane = t_ & 63; F.wave = __builtin_amdgcn_readfirstlane(t_ >> 6); } while (0)
#ifndef ONLY_PHASE
#define ONLY_PHASE -1
#endif
#define IN(k) ((ONLY_PHASE < 0 || ONLY_PHASE == (k)) && a.ph_lo <= (k) && (k) < a.ph_hi)
    bf16_t* const H = (bf16_t*)(ws + WS_H); bf16_t* const U = (bf16_t*)(ws + WS_U); bf16_t* const Y = (bf16_t*)(ws + WS_Y); bf16_t* const TP = (bf16_t*)(ws + WS_TP);
    bf16_t* const CST = (bf16_t*)(ws + WS_CST); float* const NLOC = (float*)(ws + WS_NLOC); float* const GCH = (float*)(ws + WS_GCH); float* const GATES = (float*)(ws + WS_GATES);
    bf16_t* const MEMN = (bf16_t*)(ws + WS_MEMN); bf16_t* const KVCA = (bf16_t*)(ws + WS_KVCA); bf16_t* const QCA = (bf16_t*)(ws + WS_QCA); bf16_t* const OCA = (bf16_t*)(ws + WS_OCA); bf16_t* const HID = (bf16_t*)(ws + WS_HID);
    const float2* const TW = (const float2*)(ws + WS_TW); const float2* const RP = (const float2*)(ws + WS_ROPE);

    for (int l = a.layer_lo; l < a.layer_hi; ++l) {
        const float* out_gain = a.in[12] + (size_t)l * DM;
        if (IN(0)) { PHASE_BEGIN(); p0_prep(F, a, l); GRID_BAR(); }
        if (IN(1)) { PHASE_BEGIN();
            { pg8::Gemm g{H, (const bf16_t*)(ws + WS_WIN), NTOK, NINP, DM}; pg8::StaticOrder S; S.init(NTOK, NINP, F.G, F.bid); pg8::EpiU E{U, GATES}; pg8::gemm_phase(F.lds, g, S, E); }
            { pg8::Gemm g{MEMN, (const bf16_t*)(ws + WS_WCAKV), NMEM, 1024, DM}; pg8::StaticOrder S; S.init(NMEM, 1024, F.G, (F.bid + 128) % F.G); pg8::EpiBf<0> E{KVCA, 1024}; pg8::gemm_phase(F.lds, g, S, E); }
            GRID_BAR();
        }
        if (IN(2)) { PHASE_BEGIN();
            constexpr int J_F1 = 1280, J_M1 = 1280, J_CV = 640, J_RP = 640, J_KN = 12, NJ = J_F1 + J_M1 + J_CV + J_RP + J_KN;
            bool img = false;
            for (int job = F.bid; job < NJ; job += F.G) {
                int r = job;
                if (r < J_F1) { __syncthreads(); if (!img) { f1_gen_images(F, TW); img = true; __syncthreads(); } f1_unit(F, r, U, TP, TW); continue; } r -= J_F1;
                if (r < J_M1) { img = false; m1_unit(F, r, U, GATES, a.in[8] + l * 8, a.in[9] + l * 8, CST, NLOC, GCH); continue; } r -= J_M1;
                if (r < J_CV) { conv_job(F, r, U, Y, a.in[6] + (size_t)l * 1536, a.in[7] + (size_t)l * 512, out_gain); continue; } r -= J_CV;
                if (r < J_RP) { rope_job(F, r, U, a.in[10] + l * 128, a.in[11] + l * 128, RP); continue; } r -= J_RP;
                kvnorm_job(F, r, KVCA, a.in[19] + l * 128);
            }
            GRID_BAR();
        }
        if (IN(3)) { PHASE_BEGIN();
            m2_scan(F, CST, NLOC, GCH);
            __syncthreads();
            for (int u = F.bid; u < 512; u += F.G) { const int seq = u >> 8, h = (u >> 6) & 3, qb = u & 63; const size_t base = (size_t)seq * 16384, q0 = base + 256 * qb;
                att::attn_body<0, LDU, LDU, LDU, DM>(U + q0 * LDU + UC_AQ + h * 128, U + base * LDU + UC_AK + (h >> 1) * 128, U + base * LDU + UC_AV + (h >> 1) * 128,
                                  Y + q0 * DM + 1536 + h * 128, out_gain + 1536 + h * 128, 16384, F.ldsg); }
            const bool split = F.G > 128;
            if (!split || F.bid < 128) for (int v = F.bid; v < 128; v += (split ? 128 : F.G)) { const int seq = 2 + (v >> 5), h = (v >> 3) & 3, qb = v & 7; const size_t base = (size_t)NPROMPT + (size_t)(seq - 2) * 2048, q0 = base + 256 * qb;
                att::attn_body<0, LDU, LDU, LDU, DM>(U + q0 * LDU + UC_AQ + h * 128, U + base * LDU + UC_AK + (h >> 1) * 128, U + base * LDU + UC_AV + (h >> 1) * 128,
                                  Y + q0 * DM + 1536 + h * 128, out_gain + 1536 + h * 128, 2048, F.ldsg); }
            if (!split || F.bid >= 128) { int img_type = -1; for (int f = split ? F.bid - 128 : F.bid; f < 1280; f += (split ? F.G - 128 : F.G)) f2_unit(F, f, TP, Y, out_gain, img_type, TW); }
            GRID_BAR();
        }
        if (IN(4)) { PHASE_BEGIN();
            for (int u = F.bid; u < 1280; u += F.G) m3_unit(F, u, U, GATES, a.in[8] + l * 8, a.in[9] + l * 8, CST, NLOC, Y, out_gain);
            GRID_BAR();
        }
        if (IN(5)) { PHASE_BEGIN();
            pg8::Gemm g{Y, (const bf16_t*)(ws + WS_WOUT), NTOK, DM, DM}; pg8::StaticOrder S; S.init(NTOK, DM, F.G, F.bid);
            pg8::EpiRes E{l == 0 ? a.in[0] : F.out, l == 0 ? a.in[1] - (size_t)NPROMPT * DM : F.out, F.out}; pg8::gemm_phase(F.lds, g, S, E);
            GRID_BAR();
        }
        if (IN(6)) { PHASE_BEGIN(); rms_phase(F, a.in[14] + (size_t)l * DM); GRID_BAR(); }
        if (IN(7)) { PHASE_BEGIN();
            pg8::Gemm g{H, (const bf16_t*)(ws + WS_WCAQ), NTOK, 512, DM}; pg8::StaticOrder S; S.init(NTOK, 512, F.G, F.bid); pg8::EpiBf<0> E{QCA, 512}; pg8::gemm_phase(F.lds, g, S, E);
            GRID_BAR();
        }
        if (IN(8)) { PHASE_BEGIN();
            for (int u = F.bid; u < 640; u += F.G) { const int rbk = u >> 2, h = u & 3; const size_t t0 = (size_t)rbk * 256; const int mb = t0 < (size_t)NPROMPT ? (int)(t0 >> 14) : 2 + (int)((t0 - NPROMPT) >> 11);
                const bf16_t* kv = KVCA + (size_t)mb * 256 * 1024 + h * 128;
                att::attn_body<1, 512, 1024, 1024, 512>(QCA + t0 * 512 + h * 128, kv, kv + 512, OCA + t0 * 512 + h * 128, a.in[18] + l * 128, 256, F.ldsg); }
            GRID_BAR();
        }
        if (IN(9)) { PHASE_BEGIN();
            pg8::Gemm g{OCA, (const bf16_t*)(ws + WS_WCAO), NTOK, DM, 512}; pg8::StaticOrder S; S.init(NTOK, DM, F.G, F.bid); pg8::EpiRes E{F.out, F.out, F.out}; pg8::gemm_phase(F.lds, g, S, E);
            GRID_BAR();
        }
        if (IN(10)) { PHASE_BEGIN(); rms_phase(F, a.in[21] + (size_t)l * DM); GRID_BAR(); }
        if (IN(11)) { PHASE_BEGIN();
            pg8::Gemm g{H, (const bf16_t*)(ws + WS_WUP), NTOK, DFF, DM}; pg8::StaticOrder S; S.init(NTOK, DFF, F.G, F.bid); pg8::EpiBf<1> E{HID, DFF}; pg8::gemm_phase(F.lds, g, S, E);
            GRID_BAR();
        }
        if (IN(12)) { PHASE_BEGIN();
            pg8::Gemm g{HID, (const bf16_t*)(ws + WS_WDOWN), NTOK, DM, DFF}; pg8::StaticOrder S; S.init(NTOK, DM, F.G, F.bid); pg8::EpiRes E{F.out, F.out, F.out}; pg8::gemm_phase(F.lds, g, S, E);
            if (l + 1 < a.layer_hi) GRID_BAR();
        }
    }
#undef IN
#undef GRID_BAR
}

#if MK_MULTI
constexpr size_t WS_XSAVE = WS_END + 2 * MiB;
constexpr size_t WS_PS = WS_END + 4 * MiB;
constexpr size_t WS_SCR = WS_END + 8 * MiB;
constexpr int NCHK = 24;
__device__ __forceinline__ unsigned hmix(unsigned x) { x ^= x >> 16; x *= 0x7feb352dU; x ^= x >> 15; x *= 0x846ca68bU; x ^= x >> 16; return x; }
__device__ __forceinline__ void chk_report(unsigned* chk, int k, float got, float ref, float atol, float rtol) {
    const float err = fabsf(got - ref), tol = atol + rtol * fabsf(ref); const float ratio = (err == err) ? err / tol : 1e30f;
    if (!(ratio <= 1.f)) { atomicAdd(&chk[2 * k], 1u); atomicMax(&chk[2 * k + 1], __float_as_uint(fminf(ratio, 1e30f))); }
}
__device__ __forceinline__ int srow(int i) { return (int)(((unsigned)i * 641u + 7u) % (unsigned)NTOK); }
__global__ void chk_save_rows(const float* xp, const float* xs, const float* out, int l, float* xsave) {
    const int r = srow(blockIdx.x); const float* src = x_row(xp, xs, (float*)out, l, r);
    for (int c = threadIdx.x; c < DM; c += 256) xsave[blockIdx.x * DM + c] = src[c];
}
__global__ void chk_rms(unsigned* chk, int k, const float* xp, const float* xs, const float* out, int l, int useout, const float* g, const bf16_t* H, int nrows, const float* memp, const float* mems) {
    const int r = (int)(hmix(blockIdx.x * 977u + 13u) % (unsigned)nrows);
    const float* src = memp ? (r < 512 ? memp + (size_t)r * DM : mems + (size_t)(r - 512) * DM) : (useout ? out + (size_t)r * DM : x_row(xp, xs, (float*)out, l, r));
    __shared__ float red[256]; float s = 0.f; for (int c = threadIdx.x; c < DM; c += 256) s += src[c] * src[c];
    red[threadIdx.x] = s; __syncthreads(); for (int o = 128; o > 0; o >>= 1) { if ((int)threadIdx.x < o) red[threadIdx.x] += red[threadIdx.x + o]; __syncthreads(); }
    const float rn = rsqrtf(red[0] / DM + EPS);
    for (int c = threadIdx.x; c < DM; c += 256) chk_report(chk, k, bf2f(H[(size_t)r * DM + c]), src[c] * rn * g[c], 0.01f, 0.01f);
}
__global__ void chk_wt(unsigned* chk, int k, const float* W, int K, int N, const bf16_t* WT, int is_win) {
    const unsigned id = blockIdx.x * 256u + threadIdx.x; const unsigned h = hmix(id * 31u + 5u);
    const int nrows = is_win ? NINP : N; const int n = (int)(h % (unsigned)nrows), kk = (int)(hmix(h) % (unsigned)K);
    float ref;
    if (is_win) { const int src = n < 4096 ? n : (n < 5120 ? n + 16 : (n < 5136 ? n - 5120 + 4096 : -1)); ref = src < 0 ? 0.f : W[(size_t)kk * NIN + src]; }
    else ref = W[(size_t)kk * N + n];
    chk_report(chk, k, bf2f(WT[(size_t)n * K + kk]), ref, 1e-6f, 0.005f);
}
__global__ void chk_gemm(unsigned* chk, int k, int mode, const bf16_t* A, int M, int K, const bf16_t* Bt, int N, const void* C, int ldc, const float* xsave) {
    const int wv = blockIdx.x * 4 + (threadIdx.x >> 6), lane = threadIdx.x & 63; const unsigned h = hmix(wv * 7919u + 17u);
    int row, col, brow, si = 0;
    if (mode == 2) { si = wv & 63; row = srow(si); col = (int)(hmix(h) % (unsigned)N); brow = col; }
    else if (mode == 3) { row = (int)(h % (unsigned)M); col = (int)(hmix(h) % 16u); brow = 5120 + col; }
    else { row = (int)(h % (unsigned)M); col = (int)(hmix(h) % (unsigned)N); brow = col; }
    float s = 0.f; for (int kk = lane; kk < K; kk += 64) s += bf2f(A[(size_t)row * K + kk]) * bf2f(Bt[(size_t)brow * K + kk]);
    s = wave_sum(s);
    if (lane == 0) {
        if (mode == 0) chk_report(chk, k, bf2f(((const bf16_t*)C)[(size_t)row * ldc + col]), s, 0.02f, 0.01f);
        else if (mode == 1) { const float r = fmaxf(s, 0.f); chk_report(chk, k, bf2f(((const bf16_t*)C)[(size_t)row * ldc + col]), r * r, 0.02f, 0.012f); }
        else if (mode == 2) chk_report(chk, k, ((const float*)C)[(size_t)row * ldc + col], xsave[si * DM + col] + s, 0.01f, 0.002f);
        else chk_report(chk, k, ((const float*)C)[(size_t)row * 16 + col], s, 0.005f, 0.002f);
    }
}
__global__ void chk_conv(unsigned* chk, int k, const bf16_t* U, const bf16_t* Y, const float* cw, const float* cb, const float* gain) {
    const unsigned h = hmix(blockIdx.x * 101u + 3u); const int t = (int)(h % (unsigned)NTOK), hg = (int)(hmix(h) & 3u), c = hg * 128 + threadIdx.x; int seq, p, S; tok_seq(t, seq, p, S);
    auto z = [&](int tt) { return bf2f(U[(size_t)tt * LDU + UC_CC + c]) * bf2f(U[(size_t)tt * LDU + UC_CX + c]); };
    const float zm = p > 0 ? z(t - 1) : 0.f, z0 = z(t), zp = p < S - 1 ? z(t + 1) : 0.f;
    const float y = bf2f(U[(size_t)t * LDU + UC_CB + c]) * (cw[c] * zm + cw[512 + c] * z0 + cw[1024 + c] * zp + cb[c]);
    __shared__ float red[128]; red[threadIdx.x] = y * y; __syncthreads(); for (int o = 64; o > 0; o >>= 1) { if ((int)threadIdx.x < o) red[threadIdx.x] += red[threadIdx.x + o]; __syncthreads(); }
    chk_report(chk, k, bf2f(Y[(size_t)t * DM + 512 + c]), y * rsqrtf(red[0] / 128.f + EPS) * gain[512 + c], 0.02f, 0.015f);
}
__global__ void chk_rope(unsigned* chk, int k, const bf16_t* H, const bf16_t* WIN, const bf16_t* U, const float* qn, const float* kn) {
    const unsigned h = hmix(blockIdx.x * 211u + 9u); const int t = (int)(h % (unsigned)NTOK), hd = (int)(hmix(h) % 6u), d = threadIdx.x; int seq, p, S; tok_seq(t, seq, p, S);
    const int col = (hd < 4 ? UC_AQ + hd * 128 : UC_AK + (hd - 4) * 128) + d;
    float s = 0.f; for (int kk = 0; kk < DM; ++kk) s += bf2f(H[(size_t)t * DM + kk]) * bf2f(WIN[(size_t)col * DM + kk]);
    s = bf2f(f2bf(s));
    __shared__ float xs[128]; __shared__ float red[128]; red[d] = s * s; __syncthreads(); for (int o = 64; o > 0; o >>= 1) { if (d < o) red[d] += red[d + o]; __syncthreads(); }
    const float xn = s * rsqrtf(red[0] / 128.f + EPS) * (hd < 4 ? qn : kn)[d]; xs[d] = xn; __syncthreads();
    const int ax = d >> 6, hf = (d >> 5) & 1, f = d & 31; const float pos = (float)(ax == 0 ? (p >> 6) : (p & 63)); const float inv = powf(10000.f, -(float)f / 32.f); float sn, cs; sincosf(pos * inv, &sn, &cs);
    const float other = xs[ax * 64 + (1 - hf) * 32 + f]; const float ref = xn * cs + (hf == 0 ? -other : other) * sn;
    chk_report(chk, k, bf2f(U[(size_t)t * LDU + col]), ref, 0.03f, 0.02f);
}
__global__ void chk_kvnorm(unsigned* chk, int k, const bf16_t* MEMN, const bf16_t* WKV, const bf16_t* KV, const float* kn) {
    const unsigned h = hmix(blockIdx.x * 307u + 1u); const int r = (int)(h % (unsigned)NMEM), hd = (int)(hmix(h) & 3u), d = threadIdx.x, col = hd * 128 + d;
    float s = 0.f; for (int kk = 0; kk < DM; ++kk) s += bf2f(MEMN[(size_t)r * DM + kk]) * bf2f(WKV[(size_t)col * DM + kk]);
    s = bf2f(f2bf(s));
    __shared__ float red[128]; red[d] = s * s; __syncthreads(); for (int o = 64; o > 0; o >>= 1) { if (d < o) red[d] += red[d + o]; __syncthreads(); }
    chk_report(chk, k, bf2f(KV[(size_t)r * 1024 + col]), s * rsqrtf(red[0] / 128.f + EPS) * kn[d], 0.03f, 0.02f);
}
__device__ __forceinline__ void gate_vals(const float* gates, const float* ib, const float* fb, int t, int h, int dir, float& li, float& lf) {
    li = gates[(size_t)t * 16 + dir * 4 + h] + ib[dir * 4 + h]; const float x = gates[(size_t)t * 16 + 8 + dir * 4 + h] + fb[dir * 4 + h]; lf = fminf(x, 0.f) - log1pf(expf(-fabsf(x)));
}
__global__ void chk_prefix(const float* gates, const float* ib, const float* fb, float* PS) {
    const int id = threadIdx.x; if (id >= 48) return; const int seq = id >> 3, dir = (id >> 2) & 1, h = id & 3; const int base = seq_base(seq), S = seq < 2 ? 16384 : 2048;
    float s = 0.f; for (int p = 0; p < S; ++p) { float li, lf; gate_vals(gates, ib, fb, base + p, h, dir, li, lf); s += lf; PS[(size_t)(dir * 4 + h) * NTOK + base + p] = s; }
}
__global__ void chk_m1(unsigned* chk, int k, const bf16_t* U, const float* gates, const float* ib, const float* fb, const bf16_t* CST, const float* NLOC, const float* GCH) {
    const unsigned id = blockIdx.x * 64u + threadIdx.x; const unsigned hh = hmix(id * 13u + 77u);
    const int slot = (int)(hh % 2560u), d2 = (int)(hmix(hh) & 127u), d1 = (int)((hmix(hh) >> 8) & 127u); const int dir = slot & 1, h = (slot >> 1) & 3, cg = slot >> 3, t0 = cg * 128;
    float acc = 0.f, nacc = 0.f, run = 0.f;
    for (int i = 0; i < 128; ++i) { const int sidx = dir == 0 ? 127 - i : i; float li, lf; gate_vals(gates, ib, fb, t0 + sidx, h, dir, li, lf);
        const float e = expf(run + li); const float kk = bf2f(U[(size_t)(t0 + sidx) * LDU + UC_MK + h * 128 + d1]); acc += e * kk * bf2f(U[(size_t)(t0 + sidx) * LDU + UC_MV + h * 128 + d2]); nacc += e * kk; run += lf; }
    chk_report(chk, k, bf2f(CST[(size_t)slot * 16384 + d2 * 128 + d1]), acc * SC128, 0.05f, 0.03f);
    chk_report(chk, k, NLOC[(size_t)slot * 128 + d1], nacc * SC128, 0.05f, 0.03f);
    chk_report(chk, k, GCH[slot], run, 1e-3f, 1e-3f);
}
__global__ void chk_f1(unsigned* chk, int k, const bf16_t* U, const bf16_t* TP) {
    const unsigned id = blockIdx.x * 64u + threadIdx.x; const unsigned hh = hmix(id * 29u + 11u), h2 = hmix(hh), h3 = hmix(h2);
    const int seq = (int)(hh % 6u), g = (int)(h2 & 3u), k1 = (int)((h2 >> 4) & 127u), j = (int)((h2 >> 12) & 127u); const int N2 = seq < 2 ? 128 : 16, S = 128 * N2, s2 = (int)(h3 % (unsigned)N2), base = seq_base(seq);
    float tr = 0.f, ti = 0.f;
    for (int s1 = 0; s1 < 128; ++s1) { float gr = 0.f, gi = 0.f; const bf16_t* xr = U + (size_t)(base + N2 * s1 + s2) * LDU + UC_A + g * 128;
        for (int c = 0; c < 128; ++c) { float sn, cs; sincospif((float)((j * c) & 127) / 64.f, &sn, &cs); const float x = bf2f(xr[c]); gr += x * cs; gi -= x * sn; }
        float sn, cs; sincospif((float)((k1 * s1) & 127) / 64.f, &sn, &cs); tr += gr * cs + gi * sn; ti += gi * cs - gr * sn; }
    float sn, cs; sincospif((float)((k1 * s2) % S) * 2.f / (float)S, &sn, &cs); const float pr = tr * cs + ti * sn, pi = ti * cs - tr * sn;
    const bf16_t* tp = TP + (size_t)base * 1024 + (size_t)g * S * 256;
    chk_report(chk, k, bf2f(tp[((size_t)(k1 * 2 + 0) * N2 + s2) * 128 + j]), pr, 1.5f, 0.03f);
    chk_report(chk, k, bf2f(tp[((size_t)(k1 * 2 + 1) * N2 + s2) * 128 + j]), pi, 1.5f, 0.03f);
}
__global__ void chk_f2(unsigned* chk, int k, const bf16_t* U, const bf16_t* Y, const float* gain) {
    const unsigned hh = hmix(blockIdx.x * 53u + 19u); const int t = (int)(hh % (unsigned)NTOK), g = (int)(hmix(hh) & 3u), c = threadIdx.x; int seq, kk, S; tok_seq(t, seq, kk, S); const int base = seq_base(seq);
    float ar = 0.f, ai = 0.f;
    for (int s = 0; s < S; ++s) { float sn, cs; sincospif((float)(((long)kk * s) % S) * 2.f / (float)S, &sn, &cs); const float x = bf2f(U[(size_t)(base + s) * LDU + UC_A + g * 128 + c]); ar += x * cs; ai -= x * sn; }
    __shared__ float sar[128], sai[128], red[128]; sar[c] = ar; sai[c] = ai; __syncthreads();
    const int j = c; float z = 0.f; for (int cc = 0; cc < 128; ++cc) { float sn, cs; sincospif((float)((j * cc) & 127) / 64.f, &sn, &cs); z += sar[cc] * cs + sai[cc] * sn; }
    z *= rsqrtf((float)S * 128.f);
    red[c] = z * z; __syncthreads(); for (int o = 64; o > 0; o >>= 1) { if (c < o) red[c] += red[c + o]; __syncthreads(); }
    chk_report(chk, k, bf2f(Y[(size_t)t * DM + g * 128 + j]), z * rsqrtf(red[0] / 128.f + EPS) * gain[g * 128 + j], 0.04f, 0.03f);
}
__global__ void chk_attn(unsigned* chk, int k, const bf16_t* U, const bf16_t* Y, const float* gain, float* scr) {
    const unsigned hh = hmix(blockIdx.x * 71u + 23u); const int t = (int)(hh % (unsigned)NTOK), h = (int)(hmix(hh) & 3u), tid = threadIdx.x; int seq, p, S; tok_seq(t, seq, p, S); const int base = seq_base(seq);
    __shared__ float q[128]; __shared__ float red[256]; float* sc = scr + (size_t)blockIdx.x * 32768;
    if (tid < 128) q[tid] = bf2f(U[(size_t)t * LDU + UC_AQ + h * 128 + tid]); __syncthreads();
    float m = -1e30f; for (int s = tid; s < S; s += 256) { const bf16_t* kr = U + (size_t)(base + s) * LDU + UC_AK + (h >> 1) * 128; float d = 0.f; for (int e = 0; e < 128; ++e) d += q[e] * bf2f(kr[e]); d *= SC128; sc[s] = d; m = fmaxf(m, d); }
    red[tid] = m; __syncthreads(); for (int of = 128; of > 0; of >>= 1) { if (tid < of) red[tid] = fmaxf(red[tid], red[tid + of]); __syncthreads(); } m = red[0]; __syncthreads();
    float l = 0.f; for (int s = tid; s < S; s += 256) { const float pw = expf(sc[s] - m); sc[s] = pw; l += pw; }
    red[tid] = l; __syncthreads(); for (int of = 128; of > 0; of >>= 1) { if (tid < of) red[tid] += red[tid + of]; __syncthreads(); } l = red[0]; __syncthreads();
    float o = 0.f; if (tid < 128) for (int s = 0; s < S; ++s) o += sc[s] * bf2f(U[(size_t)(base + s) * LDU + UC_AV + (h >> 1) * 128 + tid]);
    o /= l; red[tid] = tid < 128 ? o * o : 0.f; __syncthreads(); for (int of = 128; of > 0; of >>= 1) { if (tid < of) red[tid] += red[tid + of]; __syncthreads(); }
    if (tid < 128) chk_report(chk, k, bf2f(Y[(size_t)t * DM + 1536 + h * 128 + tid]), o * rsqrtf(red[0] / 128.f + EPS) * gain[1536 + h * 128 + tid], 0.04f, 0.03f);
}
__global__ void chk_mlstm(unsigned* chk, int k, const bf16_t* U, const float* gates, const float* ib, const float* fb, const float* PS, const bf16_t* Y, const float* gain, float* scr) {
    const unsigned hh = hmix(blockIdx.x * 37u + 41u); const int t = (int)(hh % (unsigned)NTOK), h = (int)(hmix(hh) & 3u), tid = threadIdx.x; int seq, p, S; tok_seq(t, seq, p, S); const int base = seq_base(seq);
    __shared__ float q[128]; __shared__ float red[256]; float* sc = scr + (size_t)blockIdx.x * 32768;
    if (tid < 128) q[tid] = bf2f(U[(size_t)t * LDU + UC_MQ + h * 128 + tid]); __syncthreads();
    float hv = 0.f;
    for (int dir = 0; dir < 2; ++dir) {
        const float* ps = PS + (size_t)(dir * 4 + h) * NTOK; float dacc = 0.f; const int lo = dir == 0 ? 0 : p, hi = dir == 0 ? p : S - 1;
        for (int s = lo + tid; s <= hi; s += 256) { float li, lf; gate_vals(gates, ib, fb, base + s, h, dir, li, lf);
            float lw; if (dir == 0) lw = ps[base + p] - ps[base + s] + li; else lw = (s > 0 ? ps[base + s - 1] : 0.f) - (p > 0 ? ps[base + p - 1] : 0.f) + li;
            const bf16_t* kr = U + (size_t)(base + s) * LDU + UC_MK + h * 128; float d = 0.f; for (int e = 0; e < 128; ++e) d += q[e] * bf2f(kr[e]); const float w = expf(lw) * d * SC128; sc[s] = w; dacc += w; }
        red[tid] = dacc; __syncthreads(); for (int of = 128; of > 0; of >>= 1) { if (tid < of) red[tid] += red[tid + of]; __syncthreads(); } const float den = red[0]; __syncthreads();
        if (tid < 128) { float num = 0.f; for (int s = lo; s <= hi; ++s) num += sc[s] * bf2f(U[(size_t)(base + s) * LDU + UC_MV + h * 128 + tid]); hv += num / fmaxf(fabsf(den), 1.f); }
        __syncthreads();
    }
    red[tid] = tid < 128 ? hv * hv : 0.f; __syncthreads(); for (int of = 128; of > 0; of >>= 1) { if (tid < of) red[tid] += red[tid + of]; __syncthreads(); }
    if (tid < 128) { const float mo = bf2f(U[(size_t)t * LDU + UC_MO + h * 128 + tid]); chk_report(chk, k, bf2f(Y[(size_t)t * DM + 1024 + h * 128 + tid]), hv * rsqrtf(red[0] / 128.f + EPS) / (1.f + expf(-mo)) * gain[1024 + h * 128 + tid], 0.04f, 0.03f); }
}
__global__ void chk_cross(unsigned* chk, int k, const bf16_t* QCA, const bf16_t* KV, const bf16_t* OCA, const float* qn) {
    const unsigned hh = hmix(blockIdx.x * 83u + 29u); const int t = (int)(hh % (unsigned)NTOK), h = (int)(hmix(hh) & 3u), d = threadIdx.x; const int mb = t < NPROMPT ? (t >> 14) : 2 + ((t - NPROMPT) >> 11);
    __shared__ float q[128]; __shared__ float red[128]; __shared__ float sc[256];
    const float x = bf2f(QCA[(size_t)t * 512 + h * 128 + d]); red[d] = x * x; __syncthreads(); for (int of = 64; of > 0; of >>= 1) { if (d < of) red[d] += red[d + of]; __syncthreads(); }
    q[d] = bf2f(f2bf(x * rsqrtf(red[0] / 128.f + EPS) * qn[d])); __syncthreads();
    for (int j = d; j < 256; j += 128) { const bf16_t* kr = KV + (size_t)(mb * 256 + j) * 1024 + h * 128; float s = 0.f; for (int e = 0; e < 128; ++e) s += q[e] * bf2f(kr[e]); sc[j] = s * SC128; } __syncthreads();
    float m = -1e30f; for (int j = 0; j < 256; ++j) m = fmaxf(m, sc[j]); float l = 0.f, o = 0.f;
    for (int j = 0; j < 256; ++j) { const float pw = expf(sc[j] - m); l += pw; o += pw * bf2f(KV[(size_t)(mb * 256 + j) * 1024 + 512 + h * 128 + d]); }
    chk_report(chk, k, bf2f(OCA[(size_t)t * 512 + h * 128 + d]), o / l, 0.01f, 0.03f);
}
__global__ void chk_tw(unsigned* chk, int k, const float2* TW) { const int m = blockIdx.x * 256 + threadIdx.x; float sn, cs; sincospif((float)m / 8192.f, &sn, &cs); const float2 w = TW[m]; chk_report(chk, k, w.x, cs, 1e-5f, 0.f); chk_report(chk, k, w.y, sn, 1e-5f, 0.f); }
__global__ void chk_nan16(unsigned* chk, int k, const bf16_t* p, size_t n) { unsigned c = 0; for (size_t i = (size_t)blockIdx.x * 256 + threadIdx.x; i < n; i += (size_t)gridDim.x * 256) { const bf16_t v = p[i]; if ((v & 0x7f80u) == 0x7f80u) ++c; }
    if (c) { atomicAdd(&chk[2 * k], c); atomicMax(&chk[2 * k + 1], __float_as_uint((float)atomicAdd(&chk[2 * k], 0u))); } }
__global__ void chk_tp_pat(unsigned* chk, int k, const bf16_t* p, size_t n, int mode) { unsigned c = 0; for (size_t i = (size_t)blockIdx.x * 256 + threadIdx.x; i < n; i += (size_t)gridDim.x * 256) { const bf16_t v = p[i]; if ((v & 0x7f80u) == 0x7f80u) {
        const int j = (int)(i & 127), s2 = (int)((i >> 7) & 127), k1 = (int)((i >> 15) & 127); const int cls = j >= 98 ? 0 : (s2 == 0 ? 1 : (k1 == 0 ? 2 : 3)); if (cls == mode) ++c; } }
    if (c) { atomicAdd(&chk[2 * k], c); atomicMax(&chk[2 * k + 1], __float_as_uint((float)atomicAdd(&chk[2 * k], 0u))); } }
__global__ void chk_encode(const unsigned* chk, int nchk, float* out, size_t n) {
    int bad = -1; float ratio = 0.f; for (int i = 0; i < nchk; ++i) { const int li = i % 32, k = (i - li) + (li < 16 ? li : (li < 20 ? 28 + (li - 16) : li - 4)); if (chk[2 * k]) { bad = k; ratio = __uint_as_float(chk[2 * k + 1]); break; } }
    if (bad < 0) return;
    int sev = (int)floorf(log10f(fmaxf(ratio, 1.f))); sev = sev < 0 ? 0 : (sev > 20 ? 20 : sev);
    const float v = (float)(10 + bad) * powf(10.f, (float)(2 + sev));
    for (size_t i = (size_t)blockIdx.x * blockDim.x + threadIdx.x; i < n; i += (size_t)gridDim.x * blockDim.x) out[i] = v;
}
#endif

extern "C" void kernel_launch(void* const* d_in, const int* in_sizes, int n_in, void* d_out, int out_size, void* d_ws, size_t ws_size, hipStream_t stream) {
    static int grid = 0;
    if (grid == 0) {
        if (n_in != 24 || in_sizes[0] != NPROMPT * DM || out_size != NTOK * DM || ws_size < WS_END + (MK_MULTI ? 32 * MiB : 0)) {
            fprintf(stderr, "kernel_launch: unexpected shapes: n_in %d in0 %d out %d ws %zu (need %zu)\n", n_in, n_in > 0 ? in_sizes[0] : -1, out_size, ws_size, (size_t)WS_END); grid = -1; return; }
        int dev = 0, cus = 0;
        if (hipGetDevice(&dev) != hipSuccess || hipDeviceGetAttribute(&cus, hipDeviceAttributeMultiprocessorCount, dev) != hipSuccess) { grid = -1; return; }
        if (hipFuncSetAttribute((const void*)fwd, hipFuncAttributeMaxDynamicSharedMemorySize, LDS_BYTES) != hipSuccess) { fprintf(stderr, "kernel_launch: hipFuncSetAttribute failed\n"); grid = -1; return; }
        int per_cu = 0;
        if (hipOccupancyMaxActiveBlocksPerMultiprocessor(&per_cu, (const void*)fwd, 512, LDS_BYTES) != hipSuccess || per_cu < 1) fprintf(stderr, "kernel_launch: occupancy query says %d\n", per_cu);
        (void)hipGetLastError();
        grid = cus;
    }
    if (grid < 0) return;
    (void)hipMemsetAsync((char*)d_ws + WS_CTL, 0, CTL_ZERO_BYTES, stream);
    Args a{};
    for (int i = 0; i < 24; ++i) a.in[i] = (const float*)d_in[i];
    a.out = (float*)d_out; a.ws = (unsigned char*)d_ws;
#if MK_MULTI
    {
        unsigned char* ws = (unsigned char*)d_ws; unsigned* chk = (unsigned*)(ws + WS_CHK); (void)hipMemsetAsync(chk, 0, 4096, stream);
        float* xsave = (float*)(ws + WS_XSAVE); float* PS = (float*)(ws + WS_PS); float* SCR = (float*)(ws + WS_SCR);
        bf16_t* H = (bf16_t*)(ws + WS_H); bf16_t* U = (bf16_t*)(ws + WS_U); bf16_t* Y = (bf16_t*)(ws + WS_Y); bf16_t* TP = (bf16_t*)(ws + WS_TP); bf16_t* CST = (bf16_t*)(ws + WS_CST);
        float* NLOC = (float*)(ws + WS_NLOC); float* GCH = (float*)(ws + WS_GCH); float* GATES = (float*)(ws + WS_GATES); bf16_t* MEMN = (bf16_t*)(ws + WS_MEMN); bf16_t* KVCA = (bf16_t*)(ws + WS_KVCA);
        bf16_t* QCA = (bf16_t*)(ws + WS_QCA); bf16_t* OCA = (bf16_t*)(ws + WS_OCA); bf16_t* HID = (bf16_t*)(ws + WS_HID);
        bf16_t* WIN = (bf16_t*)(ws + WS_WIN); bf16_t* WOUT = (bf16_t*)(ws + WS_WOUT); bf16_t* WCAQ = (bf16_t*)(ws + WS_WCAQ); bf16_t* WCAKV = (bf16_t*)(ws + WS_WCAKV); bf16_t* WCAO = (bf16_t*)(ws + WS_WCAO); bf16_t* WUP = (bf16_t*)(ws + WS_WUP); bf16_t* WDOWN = (bf16_t*)(ws + WS_WDOWN);
        const float* const* in = a.in; float* out = a.out;
        constexpr int CPL = 32, NCK = 2;
        for (int l = 0; l < DEPTH; ++l) for (int p = 0; p < NPHASE; ++p) {
            const bool ck = l < NCK; const int kb = l * CPL;
            if (ck && (p == 5 || p == 9 || p == 12)) hipLaunchKernelGGL(chk_save_rows, dim3(64), dim3(256), 0, stream, in[0], in[1], out, p == 5 ? l : 1, xsave);
            a.layer_lo = l; a.layer_hi = l + 1; a.ph_lo = p; a.ph_hi = p + 1; hipLaunchKernelGGL(fwd, dim3(grid), dim3(512), LDS_BYTES, stream, a);
            if (!ck) continue;
            const float* og = in[12] + (size_t)l * DM;
            if (p == 0) {
                hipLaunchKernelGGL(chk_rms, dim3(64), dim3(256), 0, stream, chk, kb + 0, in[0], in[1], out, l, 0, in[4] + (size_t)l * DM, H, NTOK, (const float*)nullptr, (const float*)nullptr);
                hipLaunchKernelGGL(chk_wt, dim3(64), dim3(256), 0, stream, chk, kb + 1, in[5] + (size_t)l * DM * NIN, DM, NIN, WIN, 1);
                hipLaunchKernelGGL(chk_wt, dim3(64), dim3(256), 0, stream, chk, kb + 2, in[13] + (size_t)l * DM * DM, DM, DM, WOUT, 0);
                hipLaunchKernelGGL(chk_wt, dim3(64), dim3(256), 0, stream, chk, kb + 3, in[16] + (size_t)l * DM * 512, DM, 512, WCAQ, 0);
                hipLaunchKernelGGL(chk_wt, dim3(64), dim3(256), 0, stream, chk, kb + 4, in[17] + (size_t)l * DM * 1024, DM, 1024, WCAKV, 0);
                hipLaunchKernelGGL(chk_wt, dim3(64), dim3(256), 0, stream, chk, kb + 5, in[20] + (size_t)l * 512 * DM, 512, DM, WCAO, 0);
                hipLaunchKernelGGL(chk_wt, dim3(64), dim3(256), 0, stream, chk, kb + 6, in[22] + (size_t)l * DM * DFF, DM, DFF, WUP, 0);
                hipLaunchKernelGGL(chk_wt, dim3(64), dim3(256), 0, stream, chk, kb + 7, in[23] + (size_t)l * DFF * DM, DFF, DM, WDOWN, 0);
                hipLaunchKernelGGL(chk_rms, dim3(64), dim3(256), 0, stream, chk, kb + 8, in[0], in[1], out, l, 0, in[15] + (size_t)l * DM, MEMN, NMEM, in[2], in[3]);
            } else if (p == 1) {
                hipLaunchKernelGGL(chk_gemm, dim3(256), dim3(256), 0, stream, chk, kb + 9, 0, H, NTOK, DM, WIN, LDU, (const void*)U, LDU, (const float*)nullptr);
                hipLaunchKernelGGL(chk_gemm, dim3(64), dim3(256), 0, stream, chk, kb + 10, 3, H, NTOK, DM, WIN, 16, (const void*)GATES, 16, (const float*)nullptr);
                hipLaunchKernelGGL(chk_gemm, dim3(64), dim3(256), 0, stream, chk, kb + 11, 0, MEMN, NMEM, DM, WCAKV, 1024, (const void*)KVCA, 1024, (const float*)nullptr);
            } else if (p == 2) {
                hipLaunchKernelGGL(chk_conv, dim3(256), dim3(128), 0, stream, chk, kb + 12, U, Y, in[6] + (size_t)l * 1536, in[7] + (size_t)l * 512, og);
                hipLaunchKernelGGL(chk_rope, dim3(128), dim3(128), 0, stream, chk, kb + 13, H, WIN, U, in[10] + l * 128, in[11] + l * 128);
                hipLaunchKernelGGL(chk_kvnorm, dim3(64), dim3(128), 0, stream, chk, kb + 14, MEMN, WCAKV, KVCA, in[19] + l * 128);
                hipLaunchKernelGGL(chk_m1, dim3(64), dim3(64), 0, stream, chk, kb + 15, U, GATES, in[8] + l * 8, in[9] + l * 8, CST, NLOC, GCH);
                hipLaunchKernelGGL(chk_f1, dim3(64), dim3(64), 0, stream, chk, kb + 16, U, TP);
                hipLaunchKernelGGL(chk_tw, dim3(64), dim3(256), 0, stream, chk, kb + 28, (const float2*)(ws + WS_TW));
                hipLaunchKernelGGL(chk_tp_pat, dim3(1024), dim3(256), 0, stream, chk, kb + 29, (const bf16_t*)TP, (size_t)NPROMPT * 1024, 3);
                hipLaunchKernelGGL(chk_tp_pat, dim3(1024), dim3(256), 0, stream, chk, kb + 30, (const bf16_t*)TP, (size_t)NPROMPT * 1024, 2);
                hipLaunchKernelGGL(chk_tp_pat, dim3(1024), dim3(256), 0, stream, chk, kb + 31, (const bf16_t*)TP, (size_t)NPROMPT * 1024, 1);
            } else if (p == 3) {
                hipLaunchKernelGGL(chk_attn, dim3(64), dim3(256), 0, stream, chk, kb + 17, U, Y, og, SCR);
                hipLaunchKernelGGL(chk_f2, dim3(64), dim3(128), 0, stream, chk, kb + 18, U, Y, og);
            } else if (p == 4) {
                hipLaunchKernelGGL(chk_prefix, dim3(1), dim3(64), 0, stream, GATES, in[8] + l * 8, in[9] + l * 8, PS);
                hipLaunchKernelGGL(chk_mlstm, dim3(64), dim3(256), 0, stream, chk, kb + 19, U, GATES, in[8] + l * 8, in[9] + l * 8, PS, Y, og, SCR);
            } else if (p == 5) { hipLaunchKernelGGL(chk_gemm, dim3(64), dim3(256), 0, stream, chk, kb + 20, 2, Y, NTOK, DM, WOUT, DM, (const void*)out, DM, (const float*)xsave);
            } else if (p == 6) { hipLaunchKernelGGL(chk_rms, dim3(64), dim3(256), 0, stream, chk, kb + 21, in[0], in[1], out, l, 1, in[14] + (size_t)l * DM, H, NTOK, (const float*)nullptr, (const float*)nullptr);
            } else if (p == 7) { hipLaunchKernelGGL(chk_gemm, dim3(64), dim3(256), 0, stream, chk, kb + 22, 0, H, NTOK, DM, WCAQ, 512, (const void*)QCA, 512, (const float*)nullptr);
            } else if (p == 8) { hipLaunchKernelGGL(chk_cross, dim3(128), dim3(128), 0, stream, chk, kb + 23, QCA, KVCA, OCA, in[18] + l * 128);
            } else if (p == 9) { hipLaunchKernelGGL(chk_gemm, dim3(64), dim3(256), 0, stream, chk, kb + 24, 2, OCA, NTOK, 512, WCAO, DM, (const void*)out, DM, (const float*)xsave);
            } else if (p == 10) { hipLaunchKernelGGL(chk_rms, dim3(64), dim3(256), 0, stream, chk, kb + 25, in[0], in[1], out, l, 1, in[21] + (size_t)l * DM, H, NTOK, (const float*)nullptr, (const float*)nullptr);
            } else if (p == 11) { hipLaunchKernelGGL(chk_gemm, dim3(64), dim3(256), 0, stream, chk, kb + 26, 1, H, NTOK, DM, WUP, DFF, (const void*)HID, DFF, (const float*)nullptr);
            } else if (p == 12) { hipLaunchKernelGGL(chk_gemm, dim3(64), dim3(256), 0, stream, chk, kb + 27, 2, HID, NTOK, DFF, WDOWN, DM, (const void*)out, DM, (const float*)xsave); }
        }
        hipLaunchKernelGGL(chk_encode, dim3(1024), dim3(256), 0, stream, (const unsigned*)chk, CPL * NCK, out, (size_t)NTOK * DM);
    }
#else
    a.layer_lo = 0; a.layer_hi = DEPTH; a.ph_lo = 0; a.ph_hi = NPHASE;
    hipLaunchKernelGGL(fwd, dim3(grid), dim3(512), LDS_BYTES, stream, a);
#endif
    const hipError_t le = hipPeekAtLastError();
    if (le != hipSuccess) fprintf(stderr, "kernel_launch: launch failed: %s\n", hipGetErrorName(le));
}
```
